# Optimizing an MI355X kernel written in HIP

```python
import math
import jax, jax.numpy as jnp
from jax import lax
import numpy as np

D_MODEL = 1024
BATCH = 8
SEQ = 2048
DEPTH = 2

NORM_EPS = 1e-6
N_BRANCH = 3
N_MOD = 6

RW_HEADS = 8
RW_HEAD_DIM = 64
RW_WIDTH = RW_HEADS * RW_HEAD_DIM
RW_DECAY_LORA = 64
RW_AAA_LORA = 64
RW_GATE_LORA = 128
RW_GN_EPS = 64e-5
RW_IN = 3 * RW_WIDTH + RW_DECAY_LORA + RW_AAA_LORA + RW_GATE_LORA

SB_HEADS = 8
SB_HEAD_DIM = 64
SB_WIDTH = SB_HEADS * SB_HEAD_DIM
SB_BLOCK = 128
SB_IN = 3 * SB_WIDTH

M2_HEADS = 16
M2_HEAD_DIM = 64
M2_WIDTH = M2_HEADS * M2_HEAD_DIM
M2_STATE = 128
M2_GROUPS = 2
M2_HEADS_PER_GROUP = M2_HEADS // M2_GROUPS
M2_CONV = 4
M2_CHUNK = 128
M2_CONV_DIM = M2_WIDTH + 2 * M2_GROUPS * M2_STATE
M2_IN = M2_WIDTH + M2_CONV_DIM + M2_HEADS

GATE_IN = N_BRANCH * D_MODEL
N_IN = RW_IN + SB_IN + M2_IN + GATE_IN

D_FF = 2816
FFN_CONV = 3

kernel_name = 'hybrid_rwkv7_stickbreak_mamba2_convffn'


def split_sizes(x, sizes):
    return jnp.split(x, [int(i) for i in np.cumsum(sizes)[:-1]], axis=-1)


def rms_norm(x, g):
    xf = x.astype(jnp.float32)
    y = xf * lax.rsqrt(jnp.mean(xf * xf, axis=-1, keepdims=True) + NORM_EPS)
    return (y * g.astype(jnp.float32)).astype(x.dtype)


def token_shift(x):
    return jnp.pad(x, ((0, 0), (1, 0), (0, 0)))[:, :-1]


def causal_dwconv(x, w, b):
    k_w, seq = w.shape[0], x.shape[1]
    xp = jnp.pad(x, ((0, 0), (k_w - 1, 0), (0, 0)))
    return b + sum(w[i] * xp[:, i:i + seq] for i in range(k_w))


def rwkv7_time_mix(p, mu, w0, w2, a0, a2, g2, k_k, k_a, r_k, ln_g, ln_b):
    bsz, seq, _ = p.shape
    f32 = jnp.float32
    p = p.astype(f32)
    p = p + (token_shift(p) - p) * mu
    r, k, v, w_lo, a_lo, g_lo = split_sizes(
        p, [RW_WIDTH, RW_WIDTH, RW_WIDTH, RW_DECAY_LORA, RW_AAA_LORA, RW_GATE_LORA])
    log_w = -jax.nn.softplus(-(w0 + jnp.tanh(w_lo) @ w2)) - 0.5
    decay = jnp.exp(-jnp.exp(log_w))
    a = jax.nn.sigmoid(a0 + a_lo @ a2)
    g = jax.nn.sigmoid(g_lo) @ g2
    heads = lambda t: t.reshape(bsz, seq, RW_HEADS, RW_HEAD_DIM)
    kk = heads(k * k_k)
    kk = kk * lax.rsqrt(jnp.maximum(jnp.sum(kk * kk, axis=-1, keepdims=True), 1e-24))
    k = k * (1.0 + (a - 1.0) * k_a)
    r, k, v, decay, a = heads(r), heads(k), heads(v), heads(decay), heads(a)

    def step(state, inp):
        r_t, w_t, k_t, v_t, kk_t, a_t = inp
        sa = jnp.einsum('bhij,bhj->bhi', state, -kk_t)
        state = (state * w_t[:, :, None, :]
                 + sa[..., :, None] * (kk_t * a_t)[..., None, :]
                 + v_t[..., :, None] * k_t[..., None, :])
        return state, jnp.einsum('bhij,bhj->bhi', state, r_t)

    seq_first = lambda t: jnp.swapaxes(t, 0, 1)
    init = jnp.zeros((bsz, RW_HEADS, RW_HEAD_DIM, RW_HEAD_DIM), f32)
    _, y = lax.scan(step, init, (seq_first(r), seq_first(decay), seq_first(k),
                                 seq_first(v), seq_first(kk), seq_first(a)))
    y = seq_first(y)
    mean = jnp.mean(y, axis=-1, keepdims=True)
    var = jnp.mean(jnp.square(y - mean), axis=-1, keepdims=True)
    y = ((y - mean) * lax.rsqrt(var + RW_GN_EPS)).reshape(bsz, seq, RW_WIDTH) * ln_g + ln_b
    bonus = jnp.sum(r * k * r_k, axis=-1, keepdims=True) * v
    y = y + bonus.reshape(bsz, seq, RW_WIDTH)
    return y * g


def stick_breaking_attention(q, k, v):
    bsz, seq, n_h, d_h = q.shape
    n_blk = seq // SB_BLOCK
    scale = d_h ** -0.5
    q_blocks = jnp.moveaxis(q.reshape(bsz, n_blk, SB_BLOCK, n_h, d_h), 1, 0)
    k_pos = jnp.arange(seq)

    def block(args):
        q_blk, blk_idx = args
        q_pos = blk_idx * SB_BLOCK + jnp.arange(SB_BLOCK)
        z = jnp.einsum('bqhd,bshd->bhqs', q_blk, k).astype(jnp.float32) * scale
        causal = k_pos[None, :] < q_pos[:, None]
        log_beta = jax.nn.log_sigmoid(z)
        log_1m = jnp.where(causal, jax.nn.log_sigmoid(-z), 0.0)
        later = lax.cumsum(log_1m, axis=3, reverse=True) - log_1m
        att = jnp.where(causal, jnp.exp(log_beta + later), 0.0)
        return jnp.einsum('bhqs,bshd->bqhd', att.astype(v.dtype), v)

    out = lax.map(block, (q_blocks, jnp.arange(n_blk)))
    return jnp.moveaxis(out, 0, 1).reshape(bsz, seq, n_h * d_h)


def segsum(a):
    t = a.shape[-1]
    x = jnp.broadcast_to(a[..., :, None], a.shape + (t,))
    strict = jnp.tril(jnp.ones((t, t), dtype=bool), -1)
    s = jnp.cumsum(jnp.where(strict, x, 0.0), axis=-2)
    return jnp.where(jnp.tril(jnp.ones((t, t), dtype=bool)), s, -jnp.inf)


def ssd_chunked_scan(xs, log_a, b_mat, c_mat):
    bsz, seq = xs.shape[:2]
    nc = seq // M2_CHUNK
    xs = xs.reshape(bsz, nc, M2_CHUNK, M2_GROUPS, M2_HEADS_PER_GROUP, M2_HEAD_DIM)
    b_mat = b_mat.reshape(bsz, nc, M2_CHUNK, M2_GROUPS, M2_STATE)
    c_mat = c_mat.reshape(bsz, nc, M2_CHUNK, M2_GROUPS, M2_STATE)
    log_a = log_a.reshape(bsz, nc, M2_CHUNK, M2_GROUPS, M2_HEADS_PER_GROUP).transpose(0, 3, 4, 1, 2)
    a_cum = jnp.cumsum(log_a, axis=-1)
    decay_in = jnp.exp(segsum(log_a))
    cb = jnp.einsum('bclgn,bcsgn->bgcls', c_mat, b_mat)
    y_diag = jnp.einsum('bghcls,bcsghp->bclghp', cb[:, :, None] * decay_in, xs)
    decay_to_end = jnp.exp(a_cum[..., -1:] - a_cum)
    states = jnp.einsum('bclgn,bghcl,bclghp->bcghpn', b_mat, decay_to_end, xs)
    states = jnp.concatenate([jnp.zeros_like(states[:, :1]), states], axis=1)
    chunk_decay = jnp.exp(segsum(jnp.pad(a_cum[..., -1], ((0, 0), (0, 0), (0, 0), (1, 0)))))
    states = jnp.einsum('bghzc,bcghpn->bzghpn', chunk_decay, states)[:, :-1]
    y_off = jnp.einsum('bclgn,bcghpn,bghcl->bclghp', c_mat, states, jnp.exp(a_cum))
    return (y_diag + y_off).reshape(bsz, seq, M2_HEADS, M2_HEAD_DIM)


def mamba2_mix(p, conv_w, conv_b, dt_bias, a_log, d_skip, norm_g):
    bsz, seq, _ = p.shape
    f32 = jnp.float32
    p = p.astype(f32)
    z, xbc, dt = split_sizes(p, [M2_WIDTH, M2_CONV_DIM, M2_HEADS])
    xbc = jax.nn.silu(causal_dwconv(xbc, conv_w.astype(f32), conv_b.astype(f32)))
    xs, b_mat, c_mat = split_sizes(xbc, [M2_WIDTH, M2_GROUPS * M2_STATE, M2_GROUPS * M2_STATE])
    xs = xs.reshape(bsz, seq, M2_HEADS, M2_HEAD_DIM)
    dt = jax.nn.softplus(dt + dt_bias)
    log_a = dt * -jnp.exp(a_log.astype(f32))
    grp = (bsz, seq, M2_GROUPS, M2_HEADS_PER_GROUP)
    y = ssd_chunked_scan((xs * dt[..., None]).reshape(grp + (M2_HEAD_DIM,)),
                         log_a.reshape(grp),
                         b_mat.reshape(bsz, seq, M2_GROUPS, M2_STATE),
                         c_mat.reshape(bsz, seq, M2_GROUPS, M2_STATE))
    y = y + d_skip[:, None] * xs
    y = y.reshape(bsz, seq, M2_WIDTH) * jax.nn.silu(z)
    yg = y.reshape(bsz, seq, M2_GROUPS, M2_WIDTH // M2_GROUPS)
    yg = yg * lax.rsqrt(jnp.mean(yg * yg, axis=-1, keepdims=True) + NORM_EPS)
    return yg.reshape(bsz, seq, M2_WIDTH) * norm_g


def setup_inputs(seed: int = 0) -> dict:
    key = jax.random.key(seed)
    ks = iter(jax.random.split(key, 40))
    nrm = lambda shape, scale: jax.random.normal(next(ks), shape, jnp.float32) * scale
    unif = lambda shape, lo, hi: jax.random.uniform(next(ks), shape, jnp.float32, lo, hi)
    L, D = DEPTH, D_MODEL
    dt0 = jnp.exp(unif((L, M2_HEADS), math.log(1e-3), math.log(1e-1)))
    return {
        'x': nrm((BATCH, SEQ, D), 1.0),
        'c': nrm((BATCH, D), 1.0),
        'ada_w': nrm((L, D, N_MOD * D), D ** -0.5),
        'ada_b': nrm((L, N_MOD * D), 0.02),
        'norm1_g': 1.0 + nrm((L, D), 0.02),
        'norm2_g': 1.0 + nrm((L, D), 0.02),
        'w_in': nrm((L, D, N_IN), D ** -0.5),
        'rw_mu': unif((L, RW_IN), 0.0, 1.0),
        'rw_w0': unif((L, RW_WIDTH), -7.0, -2.0),
        'rw_w2': nrm((L, RW_DECAY_LORA, RW_WIDTH), 0.5 * RW_DECAY_LORA ** -0.5),
        'rw_a0': nrm((L, RW_WIDTH), 0.1),
        'rw_a2': nrm((L, RW_AAA_LORA, RW_WIDTH), 0.5 * RW_AAA_LORA ** -0.5),
        'rw_g2': nrm((L, RW_GATE_LORA, RW_WIDTH), RW_GATE_LORA ** -0.5),
        'rw_k_k': 0.85 + nrm((L, RW_WIDTH), 0.02),
        'rw_k_a': 1.0 + nrm((L, RW_WIDTH), 0.02),
        'rw_r_k': nrm((L, RW_HEADS, RW_HEAD_DIM), 0.1),
        'rw_ln_g': 1.0 + nrm((L, RW_WIDTH), 0.02),
        'rw_ln_b': nrm((L, RW_WIDTH), 0.02),
        'rw_wo': nrm((L, RW_WIDTH, D), RW_WIDTH ** -0.5),
        'sb_wo': nrm((L, SB_WIDTH, D), SB_WIDTH ** -0.5),
        'm2_conv_w': nrm((L, M2_CONV, M2_CONV_DIM), M2_CONV ** -0.5),
        'm2_conv_b': nrm((L, M2_CONV_DIM), 0.02),
        'm2_dt_bias': dt0 + jnp.log(-jnp.expm1(-dt0)),
        'm2_a_log': jnp.log(unif((L, M2_HEADS), 1.0, 16.0)),
        'm2_d': 1.0 + nrm((L, M2_HEADS), 0.02),
        'm2_norm_g': 1.0 + nrm((L, M2_WIDTH), 0.02),
        'm2_wo': nrm((L, M2_WIDTH, D), M2_WIDTH ** -0.5),
        'w_out': nrm((L, D, D), D ** -0.5),
        'ffn_w_up': nrm((L, D, 2 * D_FF), D ** -0.5),
        'ffn_conv_w': nrm((L, FFN_CONV, 2 * D_FF), FFN_CONV ** -0.5),
        'ffn_conv_b': nrm((L, 2 * D_FF), 0.02),
        'ffn_w_down': nrm((L, D_FF, D), D_FF ** -0.5),
        'final_norm_g': 1.0 + nrm((D,), 0.02),
    }


def reference(x, c, ada_w, ada_b, norm1_g, norm2_g, w_in, rw_mu, rw_w0, rw_w2, rw_a0,
              rw_a2, rw_g2, rw_k_k, rw_k_a, rw_r_k, rw_ln_g, rw_ln_b, rw_wo, sb_wo,
              m2_conv_w, m2_conv_b, m2_dt_bias, m2_a_log, m2_d, m2_norm_g, m2_wo, w_out,
              ffn_w_up, ffn_conv_w, ffn_conv_b, ffn_w_down, final_norm_g):
    bsz, seq, _ = x.shape
    c_act = jax.nn.silu(c)
    for l in range(DEPTH):
        mod = (c_act @ ada_w[l] + ada_b[l])[:, None, :]
        shift1, scale1, gate1, shift2, scale2, gate2 = jnp.split(mod, N_MOD, axis=-1)

        h = rms_norm(x, norm1_g[l]) * (1.0 + scale1) + shift1
        p_rw, p_sb, p_m2, p_gate = split_sizes(h @ w_in[l], [RW_IN, SB_IN, M2_IN, GATE_IN])
        y_rw = rwkv7_time_mix(p_rw, rw_mu[l], rw_w0[l], rw_w2[l], rw_a0[l], rw_a2[l],
                              rw_g2[l], rw_k_k[l], rw_k_a[l], rw_r_k[l], rw_ln_g[l],
                              rw_ln_b[l]).astype(h.dtype) @ rw_wo[l]
        q, k, v = [t.reshape(bsz, seq, SB_HEADS, SB_HEAD_DIM) for t in jnp.split(p_sb, 3, axis=-1)]
        y_sb = stick_breaking_attention(q, k, v) @ sb_wo[l]
        y_m2 = mamba2_mix(p_m2, m2_conv_w[l], m2_conv_b[l], m2_dt_bias[l], m2_a_log[l],
                          m2_d[l], m2_norm_g[l]).astype(h.dtype) @ m2_wo[l]
        gates = jax.nn.sigmoid(p_gate).reshape(bsz, seq, N_BRANCH, D_MODEL)
        merged = gates[:, :, 0] * y_rw + gates[:, :, 1] * y_sb + gates[:, :, 2] * y_m2
        x = x + gate1 * (merged @ w_out[l])

        h = rms_norm(x, norm2_g[l]) * (1.0 + scale2) + shift2
        u = causal_dwconv(h @ ffn_w_up[l], ffn_conv_w[l], ffn_conv_b[l])
        u_gate, u_val = jnp.split(u, 2, axis=-1)
        x = x + gate2 * ((jax.nn.silu(u_gate) * u_val) @ ffn_w_down[l])
    return rms_norm(x, final_norm_g)
```

```cpp
#include <hip/hip_runtime.h>
#include <hip/hip_cooperative_groups.h>
#include <cstdio>
#include <cstdint>
namespace cg = cooperative_groups;
#ifndef PROBE_MASK
#define PROBE_MASK 0
#endif
namespace pg8 {
#define PG8_LAS __attribute__((address_space(3)))
typedef unsigned short bf16_t;
typedef short bf16x8 __attribute__((ext_vector_type(8)));
typedef float f32x4 __attribute__((ext_vector_type(4)));
typedef unsigned u32x4 __attribute__((ext_vector_type(4)));
constexpr int BM = 256, BK = 64, HALF = 128, HTB = HALF * BK * 2  , STAGE_BYTES = 8 * HTB, NXCD = 8, WGM = 8;

__host__ __device__ __forceinline__ int lds_byte(int r, int c) { const int st = (r >> 4) * 2 + (c >> 5), rr = r & 15, cc = c & 31, ob = rr * 64 + cc * 2; return st * 1024 + (ob ^ (((ob >> 9) & 1) << 5)); }
__host__ __device__ __forceinline__ void stage_rc(int b, int& R, int& C) { const int st = b / 1024, sb = b % 1024, swz = sb ^ (((sb >> 9) & 1) << 5); R = (st >> 1) * 16 + swz / 64; C = (st & 1) * 32 + (swz % 64) / 2; }
__host__ __device__ __forceinline__ int perm32(int rho) { const int n = rho >> 4, i = rho & 15; return 8 * (i >> 2) + 4 * n + (i & 3); }

struct Unit { int pm, pn; };
struct Gemm { const bf16_t* A; const bf16_t* Bt; int M, N, K; };

struct StaticOrder {
    int nM, nN, nwg, G, c;
    __host__ __device__ void init(int M, int N, int G_, int c_) { nM = M / BM; nN = N / BM; nwg = nM * nN; G = G_; c = c_; }
    __host__ __device__ bool next(int i, Unit& u) const {
        const long L = (long)i * G + c; if (L >= nwg) return false;
        int wgid = (int)L; { const int q = nwg / NXCD, r = nwg % NXCD, xcd = wgid % NXCD, off = wgid / NXCD; wgid = (xcd < r ? xcd * (q + 1) : r * (q + 1) + (xcd - r) * q) + off; }
        const int nig = WGM * nN, gid = wgid / nig, fm = gid * WGM, gsz = (nM - fm) < WGM ? (nM - fm) : WGM;
        u.pm = fm + ((wgid % nig) % gsz); u.pn = (wgid % nig) / gsz; return true;
    }
    __device__ __forceinline__ void a_ready(const Unit&) const {}
    __device__ __forceinline__ void done(const Unit&) const {}
};

__device__ __forceinline__ unsigned cvt_pk_bf16(float lo, float hi) { unsigned r; asm volatile("v_cvt_pk_bf16_f32 %0, %1, %2" : "=v"(r) : "v"(lo), "v"(hi)); return r; }
typedef float f32x2 __attribute__((ext_vector_type(2)));
template <class Epi, class Sched, bool ALIGN_EPI = false, bool SP2 = false>
__device__ __forceinline__ void gemm_phase(PG8_LAS unsigned char* lds, const Gemm g, const Sched& S, const Epi& E) {
    int tid_l = threadIdx.x; asm volatile("" : "+v"(tid_l)); const int tid = tid_l, wid = __builtin_amdgcn_readfirstlane(tid >> 6), lane = tid & 63, wr = wid >> 2, wc = wid & 3, fr = lane & 15, fq = lane >> 4;
    const int K = g.K, nt = K / BK;
    unsigned voffA[2], voffB[2];
#pragma unroll
    for (int i = 0; i < 2; ++i) { int R, C; stage_rc(tid * 16 + i * 8192, R, C); const int Rb = Epi::PERM ? ((R & ~31) + perm32(R & 31)) : R;
        voffA[i] = (unsigned)(R * K + C) * 2u; voffB[i] = (unsigned)(Rb * K + C) * 2u; }
    const size_t kstep = (size_t)(BK * 2);
    const size_t hstep = (size_t)HALF * K * 2;
    const size_t tstep = 2 * hstep;
    const unsigned ldsw = (unsigned)wid * 1024u;
    const int aoff = lds_byte(wr * 64 + fr, fq * 8), boff = lds_byte(wc * 32 + fr, fq * 8);
#define PG8_SA(b, h) (((b) * 2 + (h)) * HTB)
#define PG8_SB(b, h) ((4 + (b) * 2 + (h)) * HTB)
#define PG8_STAGE(bufoff, gbase, voff) do { _Pragma("unroll") for (int _i = 0; _i < 2; ++_i) \
        __builtin_amdgcn_global_load_lds((const unsigned*)((const char*)(gbase) + (voff)[_i]), (PG8_LAS unsigned*)(lds + (bufoff) + ldsw + _i * 8192), 16, 0, 0); } while (0)
#define PG8_LDA(dst, b, h) do { _Pragma("unroll") for (int m = 0; m < 4; ++m) _Pragma("unroll") for (int k = 0; k < 2; ++k) dst[m][k] = *(const PG8_LAS bf16x8*)(lds + PG8_SA(b, h) + aoff + m * 2048 + k * 1024); } while (0)
#define PG8_LDB(dst, b, h) do { _Pragma("unroll") for (int n = 0; n < 2; ++n) _Pragma("unroll") for (int k = 0; k < 2; ++k) dst[n][k] = *(const PG8_LAS bf16x8*)(lds + PG8_SB(b, h) + boff + n * 2048 + k * 1024); } while (0)
#define PG8_MMA(ai, bj, At, Bt) do { __builtin_amdgcn_s_setprio(1); _Pragma("unroll") for (int m = 0; m < 4; ++m) _Pragma("unroll") for (int n = 0; n < 2; ++n) _Pragma("unroll") for (int k = 0; k < 2; ++k) \
        acc[ai][bj][m][n] = __builtin_amdgcn_mfma_f32_16x16x32_bf16(Bt[n][k], At[m][k], acc[ai][bj][m][n], 0, 0, 0); __builtin_amdgcn_s_setprio(0); } while (0)
#define PG8_WAIT_V(n) asm volatile("s_waitcnt vmcnt(" #n ")" ::: "memory")
#define PG8_WAIT_L(n) asm volatile("s_waitcnt lgkmcnt(" #n ")" ::: "memory")
#define PG8_BAR __builtin_amdgcn_s_barrier()
#define PG8_SCHED __builtin_amdgcn_sched_barrier(0)
    Unit cur, nxt; int ui = 0;
    if (!S.next(0, cur)) return;
    f32x4 acc[2][2][4][2];
#pragma unroll
    for (int a = 0; a < 2; ++a)
#pragma unroll
        for (int b = 0; b < 2; ++b)
#pragma unroll
            for (int m = 0; m < 4; ++m)
#pragma unroll
                for (int n = 0; n < 2; ++n) acc[a][b][m][n] = (f32x4){0.f, 0.f, 0.f, 0.f};
    bf16x8 At[4][2], B0[2][2], B1[2][2];
    const char* cA = (const char*)g.A + (size_t)cur.pm * tstep; const char* cB = (const char*)g.Bt + (size_t)cur.pn * tstep;
    S.a_ready(cur);
    if constexpr (SP2) {
        PG8_STAGE(PG8_SB(0, 0), cB, voffB); PG8_STAGE(PG8_SB(0, 1), cB + hstep, voffB); PG8_STAGE(PG8_SA(0, 0), cA, voffA); PG8_STAGE(PG8_SA(0, 1), cA + hstep, voffA);
        if (wr == 1) PG8_BAR;
        PG8_WAIT_V(2); PG8_BAR;
        PG8_STAGE(PG8_SB(1, 0), cB + kstep, voffB); PG8_STAGE(PG8_SA(1, 0), cA + kstep, voffA); PG8_STAGE(PG8_SB(1, 1), cB + hstep + kstep, voffB);
        PG8_WAIT_V(6); PG8_BAR;
    } else {
        PG8_STAGE(PG8_SB(0, 0), cB, voffB); PG8_STAGE(PG8_SA(0, 0), cA, voffA); PG8_STAGE(PG8_SB(0, 1), cB + hstep, voffB); PG8_STAGE(PG8_SA(0, 1), cA + hstep, voffA);
        if (wr == 1) PG8_BAR;
        PG8_WAIT_V(4); PG8_BAR;
        PG8_STAGE(PG8_SB(1, 0), cB + kstep, voffB); PG8_STAGE(PG8_SA(1, 0), cA + kstep, voffA); PG8_STAGE(PG8_SB(1, 1), cB + hstep + kstep, voffB);
        PG8_WAIT_V(6); PG8_BAR;
    }
    for (;;) {
        const bool has_next = S.next(ui + 1, nxt);
        const char* nA = has_next ? (const char*)g.A + (size_t)nxt.pm * tstep : cA; const char* nB = has_next ? (const char*)g.Bt + (size_t)nxt.pn * tstep : cB;
        for (int t = 0; t < nt; t += 2) {
            const bool last = (t == nt - 2);
            const char* a1 = cA + (size_t)(t + 1) * kstep;
            const char* a2 = last ? nA : cA + (size_t)(t + 2) * kstep; const char* b2 = last ? nB : cB + (size_t)(t + 2) * kstep;
            const char* a3 = a2 + kstep; const char* b3 = b2 + kstep;
            if (last && has_next) S.a_ready(nxt);
            if constexpr (SP2) {
            PG8_LDB(B0, 0, 0); PG8_LDB(B1, 0, 1); PG8_SCHED; PG8_LDA(At, 0, 0); PG8_STAGE(PG8_SA(1, 1), a1 + hstep, voffA);
            PG8_WAIT_V(8); PG8_WAIT_L(0); PG8_BAR; PG8_MMA(0, 0, At, B0); PG8_MMA(0, 1, At, B1); PG8_BAR; PG8_SCHED;
            PG8_LDA(At, 0, 1); PG8_STAGE(PG8_SB(0, 0), b2, voffB); PG8_STAGE(PG8_SB(0, 1), b2 + hstep, voffB); PG8_STAGE(PG8_SA(0, 0), a2, voffA);
            PG8_WAIT_V(8); PG8_WAIT_L(0); PG8_BAR; PG8_MMA(1, 0, At, B0); PG8_MMA(1, 1, At, B1); PG8_BAR; PG8_SCHED;
            PG8_LDB(B0, 1, 0); PG8_LDB(B1, 1, 1); PG8_SCHED; PG8_LDA(At, 1, 0); PG8_STAGE(PG8_SA(0, 1), a2 + hstep, voffA);
            PG8_WAIT_V(8); PG8_WAIT_L(0); PG8_BAR; PG8_MMA(0, 0, At, B0); PG8_MMA(0, 1, At, B1); PG8_BAR; PG8_SCHED;
            PG8_LDA(At, 1, 1); PG8_STAGE(PG8_SB(1, 0), b3, voffB); PG8_STAGE(PG8_SB(1, 1), b3 + hstep, voffB); PG8_STAGE(PG8_SA(1, 0), a3, voffA);
            PG8_WAIT_V(8); PG8_WAIT_L(0); PG8_BAR; PG8_MMA(1, 0, At, B0); PG8_MMA(1, 1, At, B1); PG8_BAR; PG8_SCHED;
            } else {
            PG8_LDB(B0, 0, 0); PG8_SCHED; PG8_LDA(At, 0, 0); PG8_STAGE(PG8_SA(1, 1), a1 + hstep, voffA);
            PG8_WAIT_L(8); PG8_BAR; PG8_WAIT_L(0); PG8_MMA(0, 0, At, B0); PG8_BAR; PG8_SCHED;
            PG8_LDB(B1, 0, 1); PG8_STAGE(PG8_SB(0, 0), b2, voffB);
            PG8_BAR; PG8_WAIT_L(0); PG8_MMA(0, 1, At, B1); PG8_BAR;
            PG8_LDA(At, 0, 1); PG8_STAGE(PG8_SA(0, 0), a2, voffA);
            PG8_BAR; PG8_WAIT_L(0); PG8_MMA(1, 0, At, B0); PG8_BAR; PG8_SCHED;
            PG8_STAGE(PG8_SB(0, 1), b2 + hstep, voffB);
            PG8_WAIT_V(6); PG8_BAR; PG8_MMA(1, 1, At, B1); PG8_BAR;
            PG8_LDB(B0, 1, 0); PG8_SCHED; PG8_LDA(At, 1, 0); PG8_STAGE(PG8_SA(0, 1), a2 + hstep, voffA);
            PG8_WAIT_L(8); PG8_BAR; PG8_WAIT_L(0); PG8_MMA(0, 0, At, B0); PG8_BAR; PG8_SCHED;
            PG8_LDB(B1, 1, 1); PG8_STAGE(PG8_SB(1, 0), b3, voffB);
            PG8_BAR; PG8_WAIT_L(0); PG8_MMA(0, 1, At, B1); PG8_BAR;
            PG8_LDA(At, 1, 1); PG8_STAGE(PG8_SA(1, 0), a3, voffA);
            PG8_BAR; PG8_WAIT_L(0); PG8_MMA(1, 0, At, B0); PG8_BAR; PG8_SCHED;
            PG8_STAGE(PG8_SB(1, 1), b3 + hstep, voffB);
            PG8_WAIT_V(6); PG8_BAR; PG8_MMA(1, 1, At, B1); PG8_BAR;
            }
        }
        if constexpr (ALIGN_EPI) { if (wr == 0) PG8_BAR; }
        if constexpr (!Epi::AFTER_DRAIN) { E(acc, cur, wr, wc, fr, fq); S.done(cur); }
        if (!has_next) break;
#pragma unroll
        for (int a = 0; a < 2; ++a)
#pragma unroll
            for (int b = 0; b < 2; ++b)
#pragma unroll
                for (int m = 0; m < 4; ++m)
#pragma unroll
                    for (int n = 0; n < 2; ++n) acc[a][b][m][n] = (f32x4){0.f, 0.f, 0.f, 0.f};
        cur = nxt; cA = nA; cB = nB; ++ui;
        if constexpr (ALIGN_EPI) { if (wr == 1) PG8_BAR; }
    }
    PG8_WAIT_V(0);
    if constexpr (!ALIGN_EPI) { if (wr == 0) PG8_BAR; }
    PG8_BAR;
    if constexpr (Epi::AFTER_DRAIN) { E.fused(acc, cur, wr, wc, fr, fq, lds, wid, lane); S.done(cur); }
#undef PG8_SA
#undef PG8_SB
#undef PG8_STAGE
#undef PG8_LDA
#undef PG8_LDB
#undef PG8_MMA
#undef PG8_WAIT_V
#undef PG8_WAIT_L
#undef PG8_BAR
#undef PG8_SCHED
}
}
typedef unsigned short bf16_t;
typedef short bf16x8 __attribute__((ext_vector_type(8)));
typedef float f32x4 __attribute__((ext_vector_type(4)));
typedef float f32x16 __attribute__((ext_vector_type(16)));
typedef float f32x2 __attribute__((ext_vector_type(2)));
typedef unsigned u32x4 __attribute__((ext_vector_type(4)));
typedef unsigned u32x2 __attribute__((ext_vector_type(2)));
#define LAS __attribute__((address_space(3)))
__device__ __forceinline__ int ltid() { int t = threadIdx.x; asm volatile("" : "+v"(t)); return t; }

constexpr int M = 16384, D = 1024, SEQ = 2048, NB = 8, NL = 2;
constexpr int NIN = 8976, RW_IN = 1792, PRW_LD = 2048, SM_N = 4096, SM_NP = 4096, G_N = 3072;
constexpr int DFF = 2816, UP_N = 5632;
constexpr int LDS_BYTES = 147456;
#ifndef PROBE_MASK
#define PROBE_MASK 0
#endif

constexpr size_t OFF_MOD   = 0;
constexpr size_t OFF_BAR   = 524288;
constexpr size_t OFF_LORA  = 589824;
constexpr size_t OFF_WDOWN = 1048576;
constexpr size_t OFF_WRW   = OFF_WDOWN + (size_t)1024 * 2816 * 2;
constexpr size_t OFF_WSM   = OFF_WRW + (size_t)2048 * 1024 * 2;
constexpr size_t OFF_WG    = OFF_WSM + (size_t)4096 * 1024 * 2;
constexpr size_t OFF_WRWO  = OFF_WG + (size_t)3072 * 1024 * 2;
constexpr size_t OFF_WSBO  = OFF_WRWO + (size_t)1024 * 512 * 2;
constexpr size_t OFF_WM2O  = OFF_WSBO + (size_t)1024 * 512 * 2;
constexpr size_t OFF_WOUT  = OFF_WM2O + (size_t)1024 * 1024 * 2;
constexpr size_t OFF_WUP   = OFF_WOUT + (size_t)1024 * 1024 * 2;
constexpr size_t OFF_XN    = OFF_WUP + (size_t)5632 * 1024 * 2;
constexpr size_t OFF_R     = OFF_XN + (size_t)M * 1024 * 2;
constexpr size_t SZ16 = (size_t)M * 512 * 2;
constexpr size_t OFF_PRW  = OFF_R;
constexpr size_t OFF_SR   = OFF_PRW + (size_t)M * PRW_LD * 2;
constexpr size_t OFF_SK   = OFF_SR + SZ16;
constexpr size_t OFF_SV   = OFF_SK + SZ16;
constexpr size_t OFF_SKK  = OFF_SV + SZ16;
constexpr size_t OFF_SKKA = OFF_SKK + SZ16;
constexpr size_t OFF_SW   = OFF_SKKA + SZ16;
constexpr size_t OFF_SG   = OFF_SW + 2 * SZ16;
constexpr size_t OFF_YRAW = OFF_R + SZ16;
constexpr size_t END_RWKV = OFF_SG + SZ16;
constexpr size_t OFF_YRW  = OFF_R;
constexpr size_t OFF_YSB  = OFF_YRW + SZ16;
constexpr size_t OFF_YM2  = OFF_YSB + SZ16;
constexpr size_t OFF_PSM  = OFF_YM2 + 2 * SZ16;
constexpr size_t END_SM   = OFF_PSM + (size_t)M * SM_NP * 2;
constexpr size_t OFF_DT   = OFF_R + 201326592;
static_assert(END_RWKV <= OFF_DT && END_SM <= OFF_DT && OFF_DT + (size_t)M * 32 <= 294125568, "dt buffer");
constexpr size_t OFF_GS   = OFF_PSM;
constexpr size_t OFF_MB   = OFF_GS + 6 * SZ16;
constexpr size_t WS_ASSUMED = 294125568;
constexpr size_t OFF_GU   = OFF_R + 33554432;
constexpr size_t OFF_UE   = OFF_GU + (size_t)M * 2816 * 2;
static_assert(END_RWKV <= WS_ASSUMED && END_SM <= WS_ASSUMED && OFF_MB + 2 * SZ16 <= WS_ASSUMED, "ws map");
static_assert(OFF_UE + (size_t)(M / 64) * 4 * 5632 * 2 <= WS_ASSUMED, "GU/UE");

struct Params {
    const float* in[33];
    float* out;
    unsigned char* ws;
};
enum { I_X = 0, I_C, I_ADAW, I_ADAB, I_N1G, I_N2G, I_WIN, I_MU, I_W0, I_W2, I_A0, I_A2, I_G2, I_KK, I_KA, I_RK, I_LNG, I_LNB,
       I_RWWO, I_SBWO, I_CONVW, I_CONVB, I_DTB, I_ALOG, I_M2D, I_M2NG, I_M2WO, I_WOUT, I_FUP, I_FCW, I_FCB, I_FDOWN, I_FNG };

__device__ __forceinline__ float bf2f(unsigned v) { return __uint_as_float(v << 16); }
__device__ __forceinline__ unsigned f2bf(float f) { unsigned u = __float_as_uint(f); return (u + 0x7fffu + ((u >> 16) & 1u)) >> 16; }
typedef __bf16 bf16x2_t __attribute__((ext_vector_type(2)));
__device__ __forceinline__ unsigned pk2(float lo, float hi) { const f32x2 v = {lo, hi}; const bf16x2_t b = __builtin_convertvector(v, bf16x2_t); return __builtin_bit_cast(unsigned, b); }
__device__ __forceinline__ float sigmoidf_(float x) { return __builtin_amdgcn_rcpf(1.0f + __expf(-x)); }
__device__ __forceinline__ float siluf_(float x) { return x * __builtin_amdgcn_rcpf(1.0f + __expf(-x)); }
__device__ __forceinline__ float softplusf_(float x) { return fmaxf(x, 0.f) + __logf(1.0f + __expf(-fabsf(x))); }
__device__ __forceinline__ float wave_sum(float v) {
#pragma unroll
    for (int o = 1; o < 64; o <<= 1) v += __shfl_xor(v, o);
    return v;
}
__device__ __forceinline__ void unpack8(u32x4 w, float* f) {
    f[0] = bf2f(w.x & 0xffffu); f[1] = bf2f(w.x >> 16); f[2] = bf2f(w.y & 0xffffu); f[3] = bf2f(w.y >> 16);
    f[4] = bf2f(w.z & 0xffffu); f[5] = bf2f(w.z >> 16); f[6] = bf2f(w.w & 0xffffu); f[7] = bf2f(w.w >> 16);
}
__device__ __forceinline__ u32x4 pack8(const float* f) {
    u32x4 w; w.x = pk2(f[0], f[1]); w.y = pk2(f[2], f[3]); w.z = pk2(f[4], f[5]); w.w = pk2(f[6], f[7]); return w;
}

#define XB_TMO      128
#define XB_XCNT(j)  (256  + 64 * (j))
#define XB_XSUB(j)  (1280 + 64 * (j))
#define XB_XGEN(j)  (2304 + 64 * (j))
#define XB_TOP      3328
#define XB_TOPGEN   3392
#define XCD_BAR_WORDS 3456
#define XB_SPIN_CAP (1u << 18)

__device__ __forceinline__ unsigned xb_ld(unsigned* p)              { return __hip_atomic_load(p, __ATOMIC_RELAXED, __HIP_MEMORY_SCOPE_AGENT); }
__device__ __forceinline__ unsigned xb_add(unsigned* p, unsigned v) { return __hip_atomic_fetch_add(p, v, __ATOMIC_RELAXED, __HIP_MEMORY_SCOPE_AGENT); }
__device__ __forceinline__ unsigned xb_xcc_id() { return (unsigned)__builtin_amdgcn_s_getreg((3 << 11) | 20) & 0xFu; }
#define XB_SPIN(cond, bar) do { unsigned _sp = 0; while (cond) { __builtin_amdgcn_s_sleep(1); \
    if ((++_sp & 255u) == 0u) { if (xb_ld(&(bar)[XB_TMO])) break; if (_sp > XB_SPIN_CAP) { atomicAdd(&(bar)[XB_TMO], 1u); break; } } } } while (0)

struct XcdBarrier {
    unsigned* bar; unsigned x;
    volatile LAS unsigned* st;
};

__device__ __forceinline__ XcdBarrier xcd_barrier_post(unsigned* bar, volatile LAS unsigned* st) {
    XcdBarrier b; b.bar = bar; b.x = xb_xcc_id(); b.st = st;
    if (threadIdx.x == 0) (void)xb_add(&bar[XB_XCNT(b.x)], 1u);
    return b;
}
__device__ __forceinline__ void xcd_barrier_complete(unsigned* bar, unsigned x, unsigned& nloc, unsigned& nx) {
    const unsigned G = gridDim.x * gridDim.y * gridDim.z;
    unsigned sum, cnt, mine, sp = 0u;
    for (;;) {
        sum = 0u; cnt = 0u; mine = 0u;
#pragma unroll
        for (unsigned j = 0; j < 16; ++j) { const unsigned c = xb_ld(&bar[XB_XCNT(j)]); sum += c; cnt += (c > 0u) ? 1u : 0u; mine = (j == x) ? c : mine; }
        if (sum == G) break;
        __builtin_amdgcn_s_sleep(1);
        if ((++sp & 255u) == 0u) { if (xb_ld(&bar[XB_TMO])) break; if (sp > XB_SPIN_CAP) { atomicAdd(&bar[XB_TMO], 1u); break; } }
    }
    nloc = mine > 0u ? mine : 1u; nx = cnt > 0u ? cnt : 1u;
}

__device__ __forceinline__ void xcd_barrier(const XcdBarrier& b) {
    asm volatile("s_waitcnt vmcnt(0)" ::: "memory");
    __syncthreads();
    if (threadIdx.x == 0) {
        unsigned* bar = b.bar;
        __builtin_amdgcn_s_waitcnt(0);
        unsigned nloc = b.st[0], nx = b.st[1];
        if (nloc == 0u) { xcd_barrier_complete(bar, b.x, nloc, nx); b.st[0] = nloc; b.st[1] = nx; }
        const unsigned old = xb_add(&bar[XB_XSUB(b.x)], 1u);
        const unsigned gen = old / nloc;
        if (old + 1u == (gen + 1u) * nloc) {
            __builtin_amdgcn_fence(__ATOMIC_RELEASE, "agent");
            asm volatile("s_waitcnt vmcnt(0)" ::: "memory");
            const unsigned og = xb_add(&bar[XB_TOP], 1u);
            const unsigned tg = og / nx;
            if (og + 1u == (tg + 1u) * nx) xb_add(&bar[XB_TOPGEN], 1u);
            else XB_SPIN(xb_ld(&bar[XB_TOPGEN]) == tg, bar);
            __builtin_amdgcn_fence(__ATOMIC_ACQUIRE, "agent");
            xb_add(&bar[XB_XGEN(b.x)], 1u);
            asm volatile("s_waitcnt vmcnt(0)" ::: "memory");
        } else {
            XB_SPIN(xb_ld(&bar[XB_XGEN(b.x)]) == gen, bar);
            __builtin_amdgcn_fence(__ATOMIC_ACQUIRE, "agent");
            asm volatile("s_waitcnt vmcnt(0)" ::: "memory");
        }
    }
    __syncthreads();
}

__device__ __forceinline__ float dpp_ror1(float v) { float r; asm volatile("s_nop 1\n\tv_mov_b32_dpp %0, %1 row_ror:1 row_mask:0xf bank_mask:0xf" : "=v"(r) : "v"(v)); return r; }
__device__ __forceinline__ float dpp_ror2(float v) { float r; asm volatile("s_nop 1\n\tv_mov_b32_dpp %0, %1 row_ror:2 row_mask:0xf bank_mask:0xf" : "=v"(r) : "v"(v)); return r; }
struct EpiX {
    static constexpr bool PERM = true, AFTER_DRAIN = false;
    int mode; bf16_t* Ob; int ldc; const bf16_t* Gs; const float* xin; const bf16_t* xinb; bf16_t* xoutb; const float* gate; const float* cw; const float* cb; bf16_t* Ue;
    __device__ __forceinline__ void ffn_epi(const f32x4 (&acc)[2][2][4][2], const pg8::Unit& u, int wr, int wc, int fr, int fq) const {
        const int j0 = u.pn * 128 + wc * 32 + 8 * fq;
#pragma unroll
        for (int n = 0; n < 2; ++n) {
            const int jn = j0 + 4 * n;
            const f32x4 wg0 = *(const f32x4*)(cw + jn), wg1 = *(const f32x4*)(cw + UP_N + jn), wg2 = *(const f32x4*)(cw + 2 * UP_N + jn), bg = *(const f32x4*)(cb + jn);
            const f32x4 wv0 = *(const f32x4*)(cw + DFF + jn), wv1 = *(const f32x4*)(cw + UP_N + DFF + jn), wv2 = *(const f32x4*)(cw + 2 * UP_N + DFF + jn), bv = *(const f32x4*)(cb + DFF + jn);
#pragma unroll
            for (int ai = 0; ai < 2; ++ai)
#pragma unroll
                for (int m = 0; m < 4; ++m) {
                    const f32x4 xg = acc[ai][0][m][n], xv = acc[ai][1][m][n];
                    const f32x4 pg = (m > 0) ? acc[ai][0][m > 0 ? m - 1 : 0][n] : (f32x4){0.f, 0.f, 0.f, 0.f};
                    const f32x4 pv = (m > 0) ? acc[ai][1][m > 0 ? m - 1 : 0][n] : (f32x4){0.f, 0.f, 0.f, 0.f};
                    float o[4];
#pragma unroll
                    for (int i = 0; i < 4; ++i) {
                        const float ga = dpp_ror1(xg[i]), gb = dpp_ror1(pg[i]), gc = dpp_ror2(xg[i]), gd = dpp_ror2(pg[i]);
                        const float va = dpp_ror1(xv[i]), vb = dpp_ror1(pv[i]), vc = dpp_ror2(xv[i]), vd = dpp_ror2(pv[i]);
                        const float g1 = (fr >= 1) ? ga : gb, g2 = (fr >= 2) ? gc : gd;
                        const float v1 = (fr >= 1) ? va : vb, v2 = (fr >= 2) ? vc : vd;
                        const float cg = bg[i] + wg0[i] * g2 + wg1[i] * g1 + wg2[i] * xg[i];
                        const float cv = bv[i] + wv0[i] * v2 + wv1[i] * v1 + wv2[i] * xv[i];
                        o[i] = siluf_(cg) * cv;
                    }
                    const int row = u.pm * 256 + ai * 128 + wr * 64 + m * 16 + fr;
                    u32x2 pk; pk.x = pk2(o[0], o[1]); pk.y = pk2(o[2], o[3]);
                    *(u32x2*)(Ob + (size_t)row * DFF + jn) = pk;
                    if ((m == 0 && fr < 2) || (m == 3 && fr >= 14)) {
                        const int grp = u.pm * 4 + ai * 2 + wr, k = (m == 0) ? fr : fr - 12;
                        bf16_t* ep = Ue + ((size_t)grp * 4 + k) * UP_N + jn;
                        u32x2 eg, ev; eg.x = pk2(xg[0], xg[1]); eg.y = pk2(xg[2], xg[3]); ev.x = pk2(xv[0], xv[1]); ev.y = pk2(xv[2], xv[3]);
                        *(u32x2*)ep = eg; *(u32x2*)(ep + DFF) = ev;
                    }
                    __builtin_amdgcn_sched_barrier(0);
                }
        }
    }
    __device__ __forceinline__ void operator()(const f32x4 (&acc)[2][2][4][2], const pg8::Unit& u, int wr, int wc, int fr, int fq) const {
        if (mode == 6) { ffn_epi(acc, u, wr, wc, fr, fq); return; }
        const int row0 = u.pm * 256 + wr * 64 + fr, col0 = u.pn * 256 + wc * 32 + 8 * fq;
#pragma unroll
        for (int ai = 0; ai < 2; ++ai)
#pragma unroll
            for (int m = 0; m < 4; ++m) {
                const int row = row0 + ai * 128 + m * 16;
#pragma unroll
                for (int bj = 0; bj < 2; ++bj) {
                    const int col = col0 + bj * 128;
                    f32x4 v0 = acc[ai][bj][m][0], v1 = acc[ai][bj][m][1];
                    if (mode == 0) {
                        u32x4 w; w.x = pk2(v0[0], v0[1]); w.y = pk2(v0[2], v0[3]); w.z = pk2(v1[0], v1[1]); w.w = pk2(v1[2], v1[3]);
                        *(u32x4*)(Ob + (size_t)row * ldc + col) = w;
                    } else if (mode == 1) {
                        u32x4 w; w.x = pk2(sigmoidf_(v0[0]), sigmoidf_(v0[1])); w.y = pk2(sigmoidf_(v0[2]), sigmoidf_(v0[3]));
                        w.z = pk2(sigmoidf_(v1[0]), sigmoidf_(v1[1])); w.w = pk2(sigmoidf_(v1[2]), sigmoidf_(v1[3]));
                        *(u32x4*)(Ob + (size_t)(col >> 10) * ((size_t)M * 1024) + (size_t)row * 1024 + (col & 1023)) = w;
                    } else if (mode <= 4) {
                        const size_t off = (size_t)row * 1024 + col;
                        const u32x4 gw = *(const u32x4*)(Gs + off);
                        float g[8]; unpack8(gw, g);
                        float t[8] = {g[0] * v0[0], g[1] * v0[1], g[2] * v0[2], g[3] * v0[3], g[4] * v1[0], g[5] * v1[1], g[6] * v1[2], g[7] * v1[3]};
                        if (mode >= 3) { float p[8]; unpack8(*(const u32x4*)(Ob + off), p);
#pragma unroll
                            for (int i = 0; i < 8; ++i) t[i] += p[i]; }
                        *(u32x4*)(Ob + off) = pack8(t);
                    } else {
                        const size_t off = (size_t)row * 1024 + col;
                        const float* gp = gate + (size_t)(row >> 11) * 6144 + col;
                        const f32x4 g0 = *(const f32x4*)gp, g1 = *(const f32x4*)(gp + 4);
                        float xr[8];
                        if (xin) { const f32x4 x0 = __builtin_nontemporal_load((const f32x4*)(xin + off)), x1 = __builtin_nontemporal_load((const f32x4*)(xin + off + 4)); xr[0] = x0[0]; xr[1] = x0[1]; xr[2] = x0[2]; xr[3] = x0[3]; xr[4] = x1[0]; xr[5] = x1[1]; xr[6] = x1[2]; xr[7] = x1[3]; }
                        else unpack8(*(const u32x4*)(xinb + off), xr);
                        const f32x4 r0 = g0 * v0, r1 = g1 * v1;
                        xr[0] += r0[0]; xr[1] += r0[1]; xr[2] += r0[2]; xr[3] += r0[3]; xr[4] += r1[0]; xr[5] += r1[1]; xr[6] += r1[2]; xr[7] += r1[3];
                        *(u32x4*)(xoutb + off) = pack8(xr);
                    }
                }
            }
    }
};

__device__ __forceinline__ void tr_item(const float* W, int K, int Nsrc, int col0, int ncols, bf16_t* WT, int nblk, LAS float* scr, int item, int lane) {
    const int kb = item / nblk, nb = item % nblk, k0 = 64 * kb, n0 = 32 * nb;
    const int nq = 4 * (lane & 7), kr = lane >> 3;
#pragma unroll
    for (int i = 0; i < 8; ++i) {
        const int kk = 8 * i + kr;
        f32x4 v = {0.f, 0.f, 0.f, 0.f};
        if (n0 + nq < ncols) v = __builtin_nontemporal_load((const f32x4*)(W + (size_t)(k0 + kk) * Nsrc + col0 + n0 + nq));
        scr[kk * 33 + nq] = v[0]; scr[kk * 33 + nq + 1] = v[1]; scr[kk * 33 + nq + 2] = v[2]; scr[kk * 33 + nq + 3] = v[3];
    }
    asm volatile("s_waitcnt lgkmcnt(0)" ::: "memory");
    const int c = lane & 7;
#pragma unroll
    for (int j = 0; j < 4; ++j) { const int nn = (lane >> 3) + 8 * j; const LAS float* s = scr + (8 * c) * 33 + nn;
        u32x4 o; o.x = pk2(s[0 * 33], s[1 * 33]); o.y = pk2(s[2 * 33], s[3 * 33]); o.z = pk2(s[4 * 33], s[5 * 33]); o.w = pk2(s[6 * 33], s[7 * 33]);
        *(u32x4*)(WT + (size_t)(n0 + nn) * K + k0 + 8 * c) = o; }
    asm volatile("s_waitcnt lgkmcnt(0)" ::: "memory");
}

__device__ __forceinline__ void phase_convert(const Params& P, int l, unsigned char* lds) {
    const int tid = ltid(), lane = tid & 63, wave = __builtin_amdgcn_readfirstlane(tid >> 6);
    LAS float* scr = (LAS float*)lds + wave * (64 * 33);
    const int gw = blockIdx.x * 8 + wave, NGW = gridDim.x * 8;
    unsigned char* ws = P.ws;
    constexpr int I0 = 16 * 56, I1 = 16 * 128, I2 = 16 * 96, I3 = 8 * 32, I4 = 8 * 32, I5 = 16 * 32, I6 = 16 * 32, I7 = 16 * 176, I8 = 44 * 32;
    constexpr int I9 = 16, I10 = 16, I11 = 32, I12 = 16 * 8;
    constexpr int NIT = I0 + I1 + I2 + I3 + I4 + I5 + I6 + I7 + I8 + I9 + I10 + I11 + I12;
    const float* win = P.in[I_WIN] + (size_t)l * 1024 * NIN;
    for (int it = gw; it < NIT; it += NGW) {
        int r = it;
        if (r < I0) { tr_item(win, 1024, NIN, 0, 1792, (bf16_t*)(ws + OFF_WRW), 56, scr, r, lane); continue; } r -= I0;
        if (r < I1) { tr_item(win, 1024, NIN, 1792, SM_N, (bf16_t*)(ws + OFF_WSM), 128, scr, r, lane); continue; } r -= I1;
        if (r < I2) { tr_item(win, 1024, NIN, 5904, 3072, (bf16_t*)(ws + OFF_WG), 96, scr, r, lane); continue; } r -= I2;
        if (r < I3) { tr_item(P.in[I_RWWO] + (size_t)l * 512 * 1024, 512, 1024, 0, 1024, (bf16_t*)(ws + OFF_WRWO), 32, scr, r, lane); continue; } r -= I3;
        if (r < I4) { tr_item(P.in[I_SBWO] + (size_t)l * 512 * 1024, 512, 1024, 0, 1024, (bf16_t*)(ws + OFF_WSBO), 32, scr, r, lane); continue; } r -= I4;
        if (r < I5) { tr_item(P.in[I_M2WO] + (size_t)l * 1024 * 1024, 1024, 1024, 0, 1024, (bf16_t*)(ws + OFF_WM2O), 32, scr, r, lane); continue; } r -= I5;
        if (r < I6) { tr_item(P.in[I_WOUT] + (size_t)l * 1024 * 1024, 1024, 1024, 0, 1024, (bf16_t*)(ws + OFF_WOUT), 32, scr, r, lane); continue; } r -= I6;
        if (r < I7) { const int kb = r / 176, nbk = r % 176, pn = nbk >> 3, q = nbk & 7, srccol = ((q >> 2) ? DFF : 0) + 128 * pn + 32 * (q & 3);
            tr_item(P.in[I_FUP] + (size_t)l * 1024 * UP_N, 1024, UP_N, srccol, 32, (bf16_t*)(ws + OFF_WUP) + (size_t)(32 * nbk) * 1024, 1, scr, kb, lane); continue; } r -= I7;
        if (r < I8) { tr_item(P.in[I_FDOWN] + (size_t)l * DFF * 1024, DFF, 1024, 0, 1024, (bf16_t*)(ws + OFF_WDOWN), 32, scr, r, lane); continue; } r -= I8;
        if (r < I9) { tr_item(P.in[I_W2] + (size_t)l * 64 * 512, 64, 512, 0, 512, (bf16_t*)(ws + OFF_LORA), 16, scr, r, lane); continue; } r -= I9;
        if (r < I10) { tr_item(P.in[I_A2] + (size_t)l * 64 * 512, 64, 512, 0, 512, (bf16_t*)(ws + OFF_LORA + 65536), 16, scr, r, lane); continue; } r -= I10;
        if (r < I11) { tr_item(P.in[I_G2] + (size_t)l * 128 * 512, 128, 512, 0, 512, (bf16_t*)(ws + OFF_LORA + 131072), 16, scr, r, lane); continue; } r -= I11;
        tr_item(win, 1024, NIN, 5888, 16, (bf16_t*)(ws + OFF_WRW) + (size_t)1792 * 1024, 8, scr, r, lane);
    }
}

__device__ __forceinline__ void phase_mod(const Params& P, unsigned char* lds) {
    const int tid = ltid();
    float* sc = (float*)lds;
    float* red = (float*)lds + 8192;
    float* mod = (float*)(P.ws + OFF_MOD);
    bool loaded = false;
    for (int item = blockIdx.x; item < 2 * 96; item += gridDim.x) {
        if (!loaded) { for (int i = tid; i < 8192; i += 512) sc[i] = siluf_(P.in[I_C][i]); loaded = true; }
        __syncthreads();
        const int l = item / 96, cb = item % 96, kg = tid >> 4, c4 = 4 * (tid & 15);
        const float* w = P.in[I_ADAW] + (size_t)l * 1024 * 6144 + cb * 64 + c4;
        f32x4 acc[8];
#pragma unroll
        for (int b = 0; b < 8; ++b) acc[b] = (f32x4){0.f, 0.f, 0.f, 0.f};
#pragma unroll 8
        for (int k = kg * 32; k < kg * 32 + 32; ++k) {
            const f32x4 wv = __builtin_nontemporal_load((const f32x4*)(w + (size_t)k * 6144));
#pragma unroll
            for (int b = 0; b < 8; ++b) acc[b] += wv * sc[b * 1024 + k];
        }
#pragma unroll
        for (int b = 0; b < 8; ++b) *(f32x4*)(red + (kg * 8 + b) * 64 + c4) = acc[b];
        __syncthreads();
        { const int b = tid >> 6, cl = tid & 63, col = cb * 64 + cl; float s = 0.f;
#pragma unroll 8
          for (int g = 0; g < 32; ++g) s += red[(g * 8 + b) * 64 + cl];
          mod[((size_t)l * 8 + b) * 6144 + col] = s + P.in[I_ADAB][(size_t)l * 6144 + col]; }
        __syncthreads();
    }
    __syncthreads();
}

__device__ __forceinline__ void phase_norm_mod(const float* x, const bf16_t* xb, const float* g, const float* shift, const float* scale, bf16_t* XN) {
    const int tid = ltid(), lane = tid & 63, wave = tid >> 6;
    const int gw = blockIdx.x * 8 + wave, NGW = gridDim.x * 8;
    for (int m = gw; m < M; m += NGW) {
        const int b = m >> 11;
        if (x) {
            const f32x4* xr = (const f32x4*)(x + (size_t)m * D) + lane;
            f32x4 v[4]; float s = 0.f;
#pragma unroll
            for (int j = 0; j < 4; ++j) { v[j] = __builtin_nontemporal_load(xr + 64 * j); s += (v[j].x * v[j].x + v[j].y * v[j].y) + (v[j].z * v[j].z + v[j].w * v[j].w); }
            const float rstd = __builtin_amdgcn_rsqf(wave_sum(s) * (1.f / D) + 1e-6f);
            unsigned long long* o8 = (unsigned long long*)(XN + (size_t)m * D) + lane;
#pragma unroll
            for (int j = 0; j < 4; ++j) {
                const int c = 4 * lane + 256 * j;
                const f32x4 gg = *(const f32x4*)(g + c), sh = *(const f32x4*)(shift + (size_t)b * 6144 + c), sl = *(const f32x4*)(scale + (size_t)b * 6144 + c);
                const f32x4 h = (v[j] * rstd * gg) * (1.0f + sl) + sh;
                o8[64 * j] = (unsigned long long)pk2(h.x, h.y) | ((unsigned long long)pk2(h.z, h.w) << 32);
            }
        } else {
            float v[2][8]; float s = 0.f;
#pragma unroll
            for (int j = 0; j < 2; ++j) { unpack8(*(const u32x4*)(xb + (size_t)m * D + 512 * j + 8 * lane), v[j]);
#pragma unroll
                for (int i = 0; i < 8; ++i) s += v[j][i] * v[j][i]; }
            const float rstd = __builtin_amdgcn_rsqf(wave_sum(s) * (1.f / D) + 1e-6f);
#pragma unroll
            for (int j = 0; j < 2; ++j) {
                const int c = 512 * j + 8 * lane; float h[8];
#pragma unroll
                for (int q = 0; q < 2; ++q) { const f32x4 gg = *(const f32x4*)(g + c + 4 * q), sh = *(const f32x4*)(shift + (size_t)b * 6144 + c + 4 * q), sl = *(const f32x4*)(scale + (size_t)b * 6144 + c + 4 * q);
#pragma unroll
                    for (int i = 0; i < 4; ++i) h[4 * q + i] = (v[j][4 * q + i] * rstd * gg[i]) * (1.0f + sl[i]) + sh[i]; }
                *(u32x4*)(XN + (size_t)m * D + c) = pack8(h);
            }
        }
    }
}
__device__ __forceinline__ void phase_final_norm(const bf16_t* xb, float* out, const float* g, const XcdBarrier& xbar_) {
    const int tid = ltid(), lane = tid & 63, wave = tid >> 6;
    const int gw = blockIdx.x * 8 + wave, NGW = gridDim.x * 8;
    u32x4 raw[8][2];
#pragma unroll
    for (int k = 0; k < 8; ++k) { const int m = gw + k * NGW;
#pragma unroll
        for (int j = 0; j < 2; ++j) { raw[k][j] = (u32x4){0u, 0u, 0u, 0u}; if (m < M) raw[k][j] = *(const u32x4*)(xb + (size_t)m * D + 512 * j + 8 * lane); } }
    asm volatile("s_waitcnt vmcnt(0)" ::: "memory");
    xcd_barrier(xbar_);
#pragma unroll
    for (int k = 0; k < 8; ++k) { const int m = gw + k * NGW;
        float v[2][8]; float s = 0.f;
#pragma unroll
        for (int j = 0; j < 2; ++j) { unpack8(raw[k][j], v[j]);
#pragma unroll
            for (int i = 0; i < 8; ++i) s += v[j][i] * v[j][i]; }
        const float rstd = __builtin_amdgcn_rsqf(wave_sum(s) * (1.f / D) + 1e-6f);
        if (m < M) {
#pragma unroll
            for (int j = 0; j < 2; ++j)
#pragma unroll
                for (int q = 0; q < 2; ++q) { const int c = 512 * j + 8 * lane + 4 * q; const f32x4 gg = *(const f32x4*)(g + c);
                    *(f32x4*)(out + (size_t)m * D + c) = (f32x4){v[j][4 * q] * rstd * gg[0], v[j][4 * q + 1] * rstd * gg[1], v[j][4 * q + 2] * rstd * gg[2], v[j][4 * q + 3] * rstd * gg[3]}; }
        }
    }
}

__device__ __forceinline__ void lerp4(const bf16_t* pc, bool hasprev, const float* mu, float* out) {
    const u32x2 cw = *(const u32x2*)pc; u32x2 pw = *(const u32x2*)(hasprev ? pc - PRW_LD : pc);
    pw.x = hasprev ? pw.x : 0u; pw.y = hasprev ? pw.y : 0u;
    const f32x4 m4 = *(const f32x4*)mu;
    const float c0 = bf2f(cw.x & 0xffffu), c1 = bf2f(cw.x >> 16), c2 = bf2f(cw.y & 0xffffu), c3 = bf2f(cw.y >> 16);
    const float p0 = bf2f(pw.x & 0xffffu), p1 = bf2f(pw.x >> 16), p2 = bf2f(pw.y & 0xffffu), p3 = bf2f(pw.y >> 16);
    out[0] = c0 + (p0 - c0) * m4[0]; out[1] = c1 + (p1 - c1) * m4[1]; out[2] = c2 + (p2 - c2) * m4[2]; out[3] = c3 + (p3 - c3) * m4[3];
}
__device__ __forceinline__ void lerp8(const bf16_t* pc, bool hasprev, const float* mu, float* out) {
    const u32x4 cw = *(const u32x4*)pc; u32x4 pw = *(const u32x4*)(hasprev ? pc - PRW_LD : pc);
    pw.x = hasprev ? pw.x : 0u; pw.y = hasprev ? pw.y : 0u; pw.z = hasprev ? pw.z : 0u; pw.w = hasprev ? pw.w : 0u;
    float c[8], p[8]; unpack8(cw, c); unpack8(pw, p);
#pragma unroll
    for (int i = 0; i < 8; ++i) out[i] = c[i] + (p[i] - c[i]) * mu[i];
}
__device__ __forceinline__ u32x2 pack4(const float* f) { u32x2 w; w.x = pk2(f[0], f[1]); w.y = pk2(f[2], f[3]); return w; }
constexpr int PL_S64 = 72, PL_S128 = 136;
__device__ __forceinline__ void phase_rwkv_pre(const Params& P, int l, unsigned char* lds) {
    const int tid = ltid(), lane = tid & 63, hw = __builtin_amdgcn_readfirstlane(tid >> 6);
    const int r32 = lane & 31, hi = lane >> 5;
    bf16_t* Lw = (bf16_t*)lds; bf16_t* La = Lw + 64 * PL_S64; bf16_t* Lg = La + 64 * PL_S64;
    unsigned char* ws = P.ws;
    const bf16_t* Prw = (const bf16_t*)(ws + OFF_PRW);
    bf16_t* Sr = (bf16_t*)(ws + OFF_SR); bf16_t* Sk = (bf16_t*)(ws + OFF_SK); bf16_t* Sv = (bf16_t*)(ws + OFF_SV);
    bf16_t* Skk = (bf16_t*)(ws + OFF_SKK); bf16_t* Skka = (bf16_t*)(ws + OFF_SKKA); float* Sw = (float*)(ws + OFF_SW); bf16_t* Sg = (bf16_t*)(ws + OFF_SG);
    const bf16_t* w2t = (const bf16_t*)(ws + OFF_LORA); const bf16_t* a2t = w2t + 512 * 64; const bf16_t* g2t = a2t + 512 * 64;
    const float* mu = P.in[I_MU] + (size_t)l * RW_IN;
    const float* w0 = P.in[I_W0] + l * 512; const float* a0 = P.in[I_A0] + l * 512;
    const float* k_k = P.in[I_KK] + l * 512; const float* k_a = P.in[I_KA] + l * 512;
    for (int tile = blockIdx.x; tile < M / 64; tile += gridDim.x) {
        {
            const int m = tile * 64 + lane; const bool hasprev = (m & (SEQ - 1)) != 0;
            const bf16_t* prow = Prw + (size_t)m * PRW_LD;
            const int jb = hw * 32;
#pragma unroll
            for (int q = 0; q < 4; ++q) {
                float x[8]; lerp8(prow + 1536 + jb + 8 * q, hasprev, mu + 1536 + jb + 8 * q, x);
#pragma unroll
                for (int i = 0; i < 8; ++i) {
                    float v = x[i];
                    if (hw < 2) { const float e2 = __expf(2.f * v); v = 1.f - 2.f * __builtin_amdgcn_rcpf(e2 + 1.f); }
                    else if (hw >= 4) v = sigmoidf_(v);
                    x[i] = v;
                }
                const u32x4 pk = pack8(x);
                if (hw < 2) *(u32x4*)(Lw + lane * PL_S64 + jb + 8 * q) = pk;
                else if (hw < 4) *(u32x4*)(La + lane * PL_S64 + (jb - 64) + 8 * q) = pk;
                else *(u32x4*)(Lg + lane * PL_S128 + (jb - 128) + 8 * q) = pk;
            }
        }
        if (hw == 7) { const int m_ = tile * 64 + lane; const u32x4 d0 = *(const u32x4*)(Prw + (size_t)m_ * PRW_LD + 1792), d1 = *(const u32x4*)(Prw + (size_t)m_ * PRW_LD + 1800);
            bf16_t* dp = (bf16_t*)(ws + OFF_DT) + (size_t)m_ * 16; *(u32x4*)dp = d0; *(u32x4*)(dp + 8) = d1; }
        __syncthreads();
        for (int ct = 0; ct < 2; ++ct) {
            const int m = tile * 64 + 32 * ct + r32; const bool hasprev = (m & (SEQ - 1)) != 0;
            const bf16_t* prow = Prw + (size_t)m * PRW_LD;
            float ss = 0.f;
#pragma unroll
            for (int rt = 0; rt < 2; ++rt)
#pragma unroll
                for (int g = 0; g < 4; ++g) { const int c4 = 64 * hw + 32 * rt + 8 * g + 4 * hi; float k0[4]; lerp4(prow + 512 + c4, hasprev, mu + 512 + c4, k0);
                    const f32x4 kk4 = *(const f32x4*)(k_k + c4);
                    const float t0 = k0[0] * kk4[0], t1 = k0[1] * kk4[1], t2 = k0[2] * kk4[2], t3 = k0[3] * kk4[3]; ss += (t0 * t0 + t1 * t1) + (t2 * t2 + t3 * t3); }
            ss += __shfl_xor(ss, 32);
            const float inv = __builtin_amdgcn_rsqf(fmaxf(ss, 1e-24f));
            for (int rt = 0; rt < 2; ++rt) {
                const int cbase = 64 * hw + 32 * rt;
                f32x16 accw = {}, acca = {}, accg = {};
#pragma unroll
                for (int k0 = 0; k0 < 64; k0 += 16) {
                    const bf16x8 aw = *(const bf16x8*)(w2t + (size_t)(cbase + r32) * 64 + k0 + 8 * hi);
                    const bf16x8 aa = *(const bf16x8*)(a2t + (size_t)(cbase + r32) * 64 + k0 + 8 * hi);
                    const bf16x8 bw = *(const bf16x8*)(Lw + (32 * ct + r32) * PL_S64 + k0 + 8 * hi);
                    const bf16x8 ba = *(const bf16x8*)(La + (32 * ct + r32) * PL_S64 + k0 + 8 * hi);
                    accw = __builtin_amdgcn_mfma_f32_32x32x16_bf16(aw, bw, accw, 0, 0, 0);
                    acca = __builtin_amdgcn_mfma_f32_32x32x16_bf16(aa, ba, acca, 0, 0, 0);
                }
#pragma unroll
                for (int k0 = 0; k0 < 128; k0 += 16) {
                    const bf16x8 ag = *(const bf16x8*)(g2t + (size_t)(cbase + r32) * 128 + k0 + 8 * hi);
                    const bf16x8 bg = *(const bf16x8*)(Lg + (32 * ct + r32) * PL_S128 + k0 + 8 * hi);
                    accg = __builtin_amdgcn_mfma_f32_32x32x16_bf16(ag, bg, accg, 0, 0, 0);
                }
                bf16_t* stg = (bf16_t*)(lds + 35840) + hw * (6 * 1024);
                float wdall[16];
#pragma unroll
                for (int g = 0; g < 4; ++g) {
                    const int c4 = cbase + 8 * g + 4 * hi;
                    float r4[4], k4[4], v4[4];
                    lerp4(prow + c4, hasprev, mu + c4, r4); lerp4(prow + 512 + c4, hasprev, mu + 512 + c4, k4); lerp4(prow + 1024 + c4, hasprev, mu + 1024 + c4, v4);
                    const f32x4 w04 = *(const f32x4*)(w0 + c4), a04 = *(const f32x4*)(a0 + c4), kk4 = *(const f32x4*)(k_k + c4), ka4 = *(const f32x4*)(k_a + c4);
                    float kkv[4], kka[4], kn[4], gg[4];
#pragma unroll
                    for (int i = 0; i < 4; ++i) {
                        const float lw = w04[i] + accw[4 * g + i];
                        const float logw = -softplusf_(-lw) - 0.5f;
                        wdall[4 * g + i] = __expf(-__expf(logw));
                        const float a = sigmoidf_(a04[i] + acca[4 * g + i]);
                        gg[i] = accg[4 * g + i];
                        const float kv_ = k4[i] * kk4[i] * inv;
                        kkv[i] = kv_; kka[i] = kv_ * a;
                        kn[i] = k4[i] * (1.0f + (a - 1.0f) * ka4[i]);
                    }
                    bf16_t* sp = stg + r32 * 32 + 8 * g + 4 * hi;
                    *(u32x2*)(sp) = pack4(r4); *(u32x2*)(sp + 1024) = pack4(kn); *(u32x2*)(sp + 2048) = pack4(v4);
                    *(u32x2*)(sp + 3072) = pack4(kkv); *(u32x2*)(sp + 4096) = pack4(kka); *(u32x2*)(sp + 5120) = pack4(gg);
                }
                asm volatile("" ::: "memory");
                {
                    const size_t mb = (size_t)(tile * 64 + 32 * ct);
                    const int rrow = lane >> 2, rch = 8 * (lane & 3);
#pragma unroll
                    for (int hf = 0; hf < 2; ++hf) {
                        const int row = 16 * hf + rrow; const size_t off = (mb + row) * 512 + cbase + rch; const bf16_t* sp = stg + row * 32 + rch;
                        const u32x4 t0 = *(const u32x4*)(sp), t1 = *(const u32x4*)(sp + 1024), t2 = *(const u32x4*)(sp + 2048), t3 = *(const u32x4*)(sp + 3072), t4 = *(const u32x4*)(sp + 4096), t5 = *(const u32x4*)(sp + 5120);
                        *(u32x4*)(Sr + off) = t0; *(u32x4*)(Sk + off) = t1; *(u32x4*)(Sv + off) = t2; *(u32x4*)(Skk + off) = t3; *(u32x4*)(Skka + off) = t4; *(u32x4*)(Sg + off) = t5;
                    }
                    asm volatile("" ::: "memory");
                    float* stf = (float*)stg;
#pragma unroll
                    for (int g = 0; g < 4; ++g) *(f32x4*)(stf + r32 * 32 + 8 * g + 4 * hi) = (f32x4){wdall[4 * g], wdall[4 * g + 1], wdall[4 * g + 2], wdall[4 * g + 3]};
                    asm volatile("" ::: "memory");
                    const int frow = lane >> 3, fch = 4 * (lane & 7);
#pragma unroll
                    for (int q = 0; q < 4; ++q) { const int row = 8 * q + frow; *(f32x4*)(Sw + (mb + row) * 512 + cbase + fch) = *(const f32x4*)(stf + row * 32 + fch); }
                    asm volatile("" ::: "memory");
                }
            }
        }
        __syncthreads();
    }
}

#define LBAR() asm volatile("s_waitcnt lgkmcnt(0)\n\ts_barrier" ::: "memory")
constexpr int SC_TC = 32, SC_STEP = 336;
__device__ __forceinline__ float dpp_xor1(float v) { return __int_as_float(__builtin_amdgcn_update_dpp(0, __float_as_int(v), 0xB1, 0xF, 0xF, false)); }
__device__ __forceinline__ float dpp_xor2(float v) { return __int_as_float(__builtin_amdgcn_update_dpp(0, __float_as_int(v), 0x4E, 0xF, 0xF, false)); }
__device__ __forceinline__ float dpp_hmir(float v) { return __int_as_float(__builtin_amdgcn_update_dpp(0, __float_as_int(v), 0x141, 0xF, 0xF, false)); }
__device__ __forceinline__ float dpp_mir(float v) { return __int_as_float(__builtin_amdgcn_update_dpp(0, __float_as_int(v), 0x140, 0xF, 0xF, false)); }
__device__ __forceinline__ float red16(float s) { s += dpp_xor1(s); s += dpp_xor2(s); s += dpp_hmir(s); s += dpp_mir(s); return s; }
constexpr int SC_T2 = 16;
__device__ __forceinline__ void phase_scan(const Params& P, unsigned char* lds) {
    const int tid = ltid(), lane = tid & 63, wave = __builtin_amdgcn_readfirstlane(tid >> 6);
    unsigned char* ws = P.ws;
    const bf16_t* Sr = (const bf16_t*)(ws + OFF_SR); const bf16_t* Sk = (const bf16_t*)(ws + OFF_SK); const bf16_t* Sv = (const bf16_t*)(ws + OFF_SV);
    const bf16_t* Skk = (const bf16_t*)(ws + OFF_SKK); const bf16_t* Skka = (const bf16_t*)(ws + OFF_SKKA); const float* Sw = (const float*)(ws + OFF_SW);
    bf16_t* Yraw = (bf16_t*)(ws + OFF_YRAW);
    float* buf = (float*)lds;
    float* ypart = (float*)lds + 2 * SC_T2 * SC_STEP;
    for (int job = blockIdx.x; job < 256; job += gridDim.x) {
        const int chain = job >> 2, rg = job & 3, b = chain >> 3, h = chain & 7;
        const size_t rowbase = (size_t)b * SEQ; const int cb = 64 * h, vb = cb + 16 * rg;
        constexpr int NCH = SEQ / SC_T2;
        f32x2 S0 = {0.f, 0.f}, S1 = {0.f, 0.f};
        const int r = lane >> 4, jg = lane & 15;
        const int lt = tid - 256;
        u32x4 ldA[4], ldB[4];
#define SC_ISSUE(LD, cc) do { if ((cc) < NCH) { const size_t m0_ = rowbase + (size_t)(cc) * SC_T2; \
            _Pragma("unroll") for (int k = 0; k < 4; ++k) { const int it = lt + 256 * k; LD[k] = (u32x4){0u, 0u, 0u, 0u}; \
                if (k == 0) { const int t = it >> 4, part = it & 15; LD[k] = *(const u32x4*)(Sw + (m0_ + t) * 512 + cb + 4 * part); } \
                else if (k < 3) { const int a = (it - 256) >> 7, rem = (it - 256) & 127, t = rem >> 3, part = rem & 7; \
                    const bf16_t* src_ = (a == 0) ? Skka : (a == 1) ? Sk : (a == 2) ? Skk : Sr; LD[k] = *(const u32x4*)(src_ + (m0_ + t) * 512 + cb + 8 * part); } \
                else if (it < 800) { const int rem = it - 768, t = rem >> 1, part = rem & 1; LD[k] = *(const u32x4*)(Sv + (m0_ + t) * 512 + vb + 8 * part); } } } } while (0)
#define SC_COMMIT(LD, cc) do { if ((cc) < NCH) { float* dst_ = buf + ((cc) & 1) * (SC_T2 * SC_STEP); \
            _Pragma("unroll") for (int k = 0; k < 4; ++k) { const int it = lt + 256 * k; \
                if (k == 0) { const int t = it >> 4, part = it & 15; *(u32x4*)(dst_ + t * SC_STEP + 4 * part) = LD[k]; } \
                else if (k < 3) { const int a = (it - 256) >> 7, rem = (it - 256) & 127, t = rem >> 3, part = rem & 7; \
                    float f[8]; unpack8(LD[k], f); float* d = dst_ + t * SC_STEP + 64 * (a + 1) + 8 * part; \
                    *(f32x4*)d = (f32x4){f[0], f[1], f[2], f[3]}; *(f32x4*)(d + 4) = (f32x4){f[4], f[5], f[6], f[7]}; } \
                else if (it < 800) { const int rem = it - 768, t = rem >> 1, part = rem & 1; \
                    float f[8]; unpack8(LD[k], f); float* d = dst_ + t * SC_STEP + 320 + 8 * part; \
                    *(f32x4*)d = (f32x4){f[0], f[1], f[2], f[3]}; *(f32x4*)(d + 4) = (f32x4){f[4], f[5], f[6], f[7]}; } } } } while (0)
#define SC_YRED(cc) do { if ((cc) >= 0) { const float* yp = ypart + ((cc) & 1) * (SC_T2 * 256) + lt * 16; \
            const f32x4 p0 = *(const f32x4*)yp, p1 = *(const f32x4*)(yp + 4), p2 = *(const f32x4*)(yp + 8), p3 = *(const f32x4*)(yp + 12); \
            const f32x4 q = (p0 + p1) + (p2 + p3); \
            Yraw[((size_t)job * SEQ + (size_t)(cc) * SC_T2) * 16 + lt] = (bf16_t)f2bf((q[0] + q[1]) + (q[2] + q[3])); } } while (0)
#define SC_SCAN(cc) do { \
            const float* src = buf + ((cc) & 1) * (SC_T2 * SC_STEP); \
            const int vrow = 4 * wave + r; \
            const float* base0 = src + jg * 4; const float* vbase = src + 320 + vrow; \
            float* ypw = ypart + ((cc) & 1) * (SC_T2 * 256) + vrow * 16 + jg; \
            for (int t = 0; t < SC_T2; t += 4) { \
                SC_LOAD(A, t) SC_LOAD(B, t + 1) \
                __builtin_amdgcn_sched_barrier(0); \
                SC_STEPF(A, t); \
                __builtin_amdgcn_sched_barrier(0); \
                SC_LOAD(C, t + 2) \
                __builtin_amdgcn_sched_barrier(0); \
                SC_STEPF(B, t + 1); \
                __builtin_amdgcn_sched_barrier(0); \
                SC_LOAD(D, t + 3) \
                __builtin_amdgcn_sched_barrier(0); \
                SC_STEPF(C, t + 2); \
                __builtin_amdgcn_sched_barrier(0); \
                SC_STEPF(D, t + 3); \
            } } while (0)
#define SC_LOAD(X, t_) const f32x4 w4##X = *(const f32x4*)(base0 + (t_) * SC_STEP), a4##X = *(const f32x4*)(base0 + (t_) * SC_STEP + 64), k4##X = *(const f32x4*)(base0 + (t_) * SC_STEP + 128), \
                    n4##X = *(const f32x4*)(base0 + (t_) * SC_STEP + 192), r4##X = *(const f32x4*)(base0 + (t_) * SC_STEP + 256); const float vi##X = vbase[(t_) * SC_STEP];
#define SC_STEPF(X, t_) do { \
                    const f32x2 acc = S0 * (f32x2){n4##X[0], n4##X[1]} + S1 * (f32x2){n4##X[2], n4##X[3]}; \
                    const float sa = -red16(acc.x + acc.y); \
                    S0 = S0 * (f32x2){w4##X[0], w4##X[1]} + ((f32x2){a4##X[0], a4##X[1]} * sa + (f32x2){k4##X[0], k4##X[1]} * vi##X); \
                    S1 = S1 * (f32x2){w4##X[2], w4##X[3]} + ((f32x2){a4##X[2], a4##X[3]} * sa + (f32x2){k4##X[2], k4##X[3]} * vi##X); \
                    const f32x2 ya = S0 * (f32x2){r4##X[0], r4##X[1]} + S1 * (f32x2){r4##X[2], r4##X[3]}; \
                    ypw[(t_) * 256] = ya.x + ya.y; } while (0)
        __syncthreads();
        if (wave >= 4) { SC_ISSUE(ldA, 0); SC_ISSUE(ldB, 1); SC_COMMIT(ldA, 0); SC_ISSUE(ldA, 2); }
        LBAR();
        for (int c = 0; c < NCH; c += 2) {
            if (wave >= 4) { SC_COMMIT(ldB, c + 1); SC_ISSUE(ldB, c + 3); SC_YRED(c - 1); }
            else SC_SCAN(c);
            LBAR();
            if (wave >= 4) { SC_COMMIT(ldA, c + 2); SC_ISSUE(ldA, c + 4); SC_YRED(c); }
            else SC_SCAN(c + 1);
            LBAR();
        }
        if (wave >= 4) SC_YRED(NCH - 1);
#undef SC_ISSUE
#undef SC_COMMIT
#undef SC_YRED
#undef SC_SCAN
#undef SC_LOAD
#undef SC_STEPF
    }
    __syncthreads();
}

__device__ __forceinline__ float red8(float s) { s += dpp_xor1(s); s += dpp_xor2(s); s += dpp_hmir(s); return s; }
__device__ __forceinline__ void phase_rwkv_post(const Params& P, int l) {
    const int tid = ltid(), lane = tid & 63, wave = tid >> 6;
    const int gw = blockIdx.x * 8 + wave, NGW = gridDim.x * 8;
    unsigned char* ws = P.ws;
    const bf16_t* Sr = (const bf16_t*)(ws + OFF_SR); const bf16_t* Sk = (const bf16_t*)(ws + OFF_SK); const bf16_t* Sv = (const bf16_t*)(ws + OFF_SV);
    const bf16_t* Sg = (const bf16_t*)(ws + OFF_SG); const bf16_t* Yraw = (const bf16_t*)(ws + OFF_YRAW);
    bf16_t* Yrw = (bf16_t*)(ws + OFF_YRW);
    const float* lng = P.in[I_LNG] + l * 512 + 8 * lane; const float* lnb = P.in[I_LNB] + l * 512 + 8 * lane; const float* rk = P.in[I_RK] + l * 512 + 8 * lane;
    float g8[8], b8[8], k8[8];
    { const f32x4 a = *(const f32x4*)lng, b = *(const f32x4*)(lng + 4); g8[0]=a[0];g8[1]=a[1];g8[2]=a[2];g8[3]=a[3];g8[4]=b[0];g8[5]=b[1];g8[6]=b[2];g8[7]=b[3]; }
    { const f32x4 a = *(const f32x4*)lnb, b = *(const f32x4*)(lnb + 4); b8[0]=a[0];b8[1]=a[1];b8[2]=a[2];b8[3]=a[3];b8[4]=b[0];b8[5]=b[1];b8[6]=b[2];b8[7]=b[3]; }
    { const f32x4 a = *(const f32x4*)rk, b = *(const f32x4*)(rk + 4); k8[0]=a[0];k8[1]=a[1];k8[2]=a[2];k8[3]=a[3];k8[4]=b[0];k8[5]=b[1];k8[6]=b[2];k8[7]=b[3]; }
    for (int m = gw; m < M; m += NGW) {
        const size_t off = (size_t)m * 512 + 8 * lane;
        float y[8], r[8], k[8], v[8], g[8];
        { const int c0 = 8 * lane, hh = c0 >> 6, ii = c0 & 63; const int jobi = ((m >> 11) * 8 + hh) * 4 + (ii >> 4);
          unpack8(*(const u32x4*)(Yraw + ((size_t)jobi * SEQ + (m & (SEQ - 1))) * 16 + (ii & 15)), y); }
        unpack8(*(const u32x4*)(Sr + off), r); unpack8(*(const u32x4*)(Sk + off), k);
        unpack8(*(const u32x4*)(Sv + off), v); unpack8(*(const u32x4*)(Sg + off), g);
        float s = 0.f, rkv = 0.f;
#pragma unroll
        for (int i = 0; i < 8; ++i) { s += y[i]; rkv += r[i] * k[i] * k8[i]; }
        const float mean = red8(s) * (1.f / 64.f); rkv = red8(rkv);
        float q = 0.f;
#pragma unroll
        for (int i = 0; i < 8; ++i) { y[i] -= mean; q += y[i] * y[i]; }
        const float rstd = __builtin_amdgcn_rsqf(red8(q) * (1.f / 64.f) + 64e-5f);
        float o[8];
#pragma unroll
        for (int i = 0; i < 8; ++i) o[i] = (y[i] * rstd * g8[i] + b8[i] + rkv * v[i]) * g[i];
        *(u32x4*)(Yrw + off) = pack8(o);
    }
}

__device__ __forceinline__ int crow(int r, int hi) { return (r & 3) + 8 * (r >> 2) + 4 * hi; }
template <bool DIAG>
__device__ __forceinline__ void attn_tile(f32x16& o0, f32x16& o1, float& C, const bf16x8 (&kf)[4], const bf16x8 (&vf)[4], const bf16x8 (&qr)[4], int kv0, int qabs, int hi) {
    f32x16 p0 = {};
#pragma unroll
    for (int d0 = 0; d0 < 4; ++d0) p0 = __builtin_amdgcn_mfma_f32_32x32x16_bf16(kf[d0], qr[d0], p0, 0, 0, 0);
    f32x16 x0;
#pragma unroll
    for (int r = 0; r < 16; ++r) {
        const float zc = fmaxf(p0[r] * 0.125f, -80.0f); const float e = __expf(-zc); float bt = __builtin_amdgcn_rcpf(1.0f + e); float om = e * bt;
        if (DIAG) { const bool cz = (kv0 + crow(r, hi)) < qabs; bt = cz ? bt : 0.f; om = cz ? om : 1.0f; }
        p0[r] = bt; x0[r] = om;
    }
    float T[4], TO[4];
#pragma unroll
    for (int g = 0; g < 4; ++g) T[g] = (x0[4 * g] * x0[4 * g + 1]) * (x0[4 * g + 2] * x0[4 * g + 3]);
#pragma unroll
    for (int g = 0; g < 4; ++g) TO[g] = __shfl_xor(T[g], 32);
    float offs[4]; float run = 1.0f;
#pragma unroll
    for (int g = 3; g >= 0; --g) { offs[g] = (hi == 0) ? run * TO[g] : run; run *= T[g] * TO[g]; }
#pragma unroll
    for (int g = 0; g < 4; ++g) {
        const float b0 = C * offs[g];
        const float s2 = x0[4 * g + 3], s1 = s2 * x0[4 * g + 2], s0 = s1 * x0[4 * g + 1];
        p0[4 * g + 0] *= b0 * s0; p0[4 * g + 1] *= b0 * s1; p0[4 * g + 2] *= b0 * s2; p0[4 * g + 3] *= b0;
    }
    C *= run;
#pragma unroll
    for (int ks = 0; ks < 2; ++ks) {
        u32x4 pw; pw.x = pk2(p0[8 * ks + 0], p0[8 * ks + 1]); pw.y = pk2(p0[8 * ks + 2], p0[8 * ks + 3]); pw.z = pk2(p0[8 * ks + 4], p0[8 * ks + 5]); pw.w = pk2(p0[8 * ks + 6], p0[8 * ks + 7]);
        const bf16x8 pa = __builtin_bit_cast(bf16x8, pw);
        o0 = __builtin_amdgcn_mfma_f32_32x32x16_bf16(pa, vf[2 * ks], o0, 0, 0, 0);
        o1 = __builtin_amdgcn_mfma_f32_32x32x16_bf16(pa, vf[2 * ks + 1], o1, 0, 0, 0);
    }
}
__device__ __forceinline__ void attn_job(const bf16_t* Psm, bf16_t* Ysb, int b, int h, int qt, int lane, bf16_t* ost) {
    const int r32 = lane & 31, hi = lane >> 5;
    const size_t rowbase = (size_t)b * SEQ; const int q0 = 32 * qt;
    const bf16_t* Qp = Psm + (rowbase + q0 + r32) * SM_NP + 64 * h + 8 * hi;
    const bf16_t* Kb = Psm + rowbase * SM_NP + 512 + 64 * h + 8 * hi;
    const bf16_t* Vb = Psm + rowbase * SM_NP + 1024 + 64 * h + r32;
    bf16x8 qr[4];
#pragma unroll
    for (int d0 = 0; d0 < 4; ++d0) qr[d0] = *(const bf16x8*)(Qp + 16 * d0);
    f32x16 o0 = {}, o1 = {};
    float C = 1.0f;
    const int qabs = q0 + r32;
    bf16x8 kf[4], vf[4], kfn[4], vfn[4];
#define ATT_LOAD(KF, VF, kv0_) do { \
        _Pragma("unroll") for (int d0 = 0; d0 < 4; ++d0) KF[d0] = *(const bf16x8*)(Kb + (size_t)((kv0_) + r32) * SM_NP + 16 * d0); \
        _Pragma("unroll") for (int ks = 0; ks < 2; ++ks) _Pragma("unroll") for (int i = 0; i < 8; ++i) { \
            const int key = (kv0_) + 16 * ks + (i & 3) + 8 * (i >> 2) + 4 * hi; const bf16_t* vp = Vb + (size_t)key * SM_NP; VF[2 * ks][i] = (short)vp[0]; VF[2 * ks + 1][i] = (short)vp[32]; } } while (0)
    ATT_LOAD(kf, vf, q0);
    if (q0 >= 32) ATT_LOAD(kfn, vfn, q0 - 32);
    attn_tile<true>(o0, o1, C, kf, vf, qr, q0, qabs, hi);
    for (int kv0 = q0 - 32; kv0 >= 0; kv0 -= 32) {
        if (__all(C < 1.0e-38f)) break;
#pragma unroll
        for (int d0 = 0; d0 < 4; ++d0) { kf[d0] = kfn[d0]; vf[d0] = vfn[d0]; }
        if (kv0 >= 32) ATT_LOAD(kfn, vfn, kv0 - 32);
        attn_tile<false>(o0, o1, C, kf, vf, qr, kv0, qabs, hi);
    }
#undef ATT_LOAD
#pragma unroll
    for (int r = 0; r < 16; ++r) { bf16_t* rp = ost + crow(r, hi) * 64 + r32; rp[0] = (bf16_t)f2bf(o0[r]); rp[32] = (bf16_t)f2bf(o1[r]); }
    asm volatile("" ::: "memory");
#pragma unroll
    for (int q = 0; q < 4; ++q) { const int row = 8 * q + (lane >> 3);
        *(u32x4*)(Ysb + (rowbase + q0 + row) * 512 + 64 * h + 8 * (lane & 7)) = *(const u32x4*)(ost + row * 64 + 8 * (lane & 7)); }
    asm volatile("" ::: "memory");
}
__device__ __forceinline__ void phase_attn(const Params& P, unsigned char* lds) {
    const int tid = ltid(), lane = tid & 63, wave = tid >> 6;
    const int gw = (blockIdx.x >> 1) * 8 + wave, NGW = (gridDim.x >> 1) * 8;
    const bf16_t* Psm = (const bf16_t*)(P.ws + OFF_PSM); bf16_t* Ysb = (bf16_t*)(P.ws + OFF_YSB);
    for (int job = gw; job < 64 * 64; job += NGW) {
        const int chain = job & 63, qt = 63 - (job >> 6);
        attn_job(Psm, Ysb, chain >> 3, chain & 7, qt, lane, (bf16_t*)lds + wave * 2048);
    }
}

__device__ __forceinline__ void phase_xbc_conv(const Params& P, int l, const XcdBarrier& xb) {
    const int tid = ltid();
    const int gtid = blockIdx.x * 512 + tid;
    bf16_t* Psm = (bf16_t*)(P.ws + OFF_PSM);
    const int cgp = gtid % 192, sgm = gtid / 192;
    const int m0 = 26 * sgm;
    const bool active = (gtid < 192 * 631) && (m0 < M);
    const int ch = 8 * cgp;
    bf16_t* colp = Psm + 2560 + ch;
    u32x4 h0 = {0u, 0u, 0u, 0u}, h1 = h0, h2 = h0;
    if (active) {
        const int t = m0 & (SEQ - 1);
        if (t >= 3) h0 = *(const u32x4*)(colp + (size_t)(m0 - 3) * SM_NP);
        if (t >= 2) h1 = *(const u32x4*)(colp + (size_t)(m0 - 2) * SM_NP);
        if (t >= 1) h2 = *(const u32x4*)(colp + (size_t)(m0 - 1) * SM_NP);
    }
    asm volatile("s_waitcnt vmcnt(0)" ::: "memory");
    xcd_barrier(xb);
    if (active) {
        const float* cw = P.in[I_CONVW] + (size_t)l * 4 * 1536 + ch; const float* cbp = P.in[I_CONVB] + (size_t)l * 1536 + ch;
        float w[4][8], bb[8];
#pragma unroll
        for (int d = 0; d < 4; ++d) { const f32x4 a = *(const f32x4*)(cw + d * 1536), b = *(const f32x4*)(cw + d * 1536 + 4);
            w[d][0] = a[0]; w[d][1] = a[1]; w[d][2] = a[2]; w[d][3] = a[3]; w[d][4] = b[0]; w[d][5] = b[1]; w[d][6] = b[2]; w[d][7] = b[3]; }
        { const f32x4 a = *(const f32x4*)cbp, b = *(const f32x4*)(cbp + 4); bb[0] = a[0]; bb[1] = a[1]; bb[2] = a[2]; bb[3] = a[3]; bb[4] = b[0]; bb[5] = b[1]; bb[6] = b[2]; bb[7] = b[3]; }
        float x0[8], x1[8], x2[8], x3[8];
        unpack8(h0, x0); unpack8(h1, x1); unpack8(h2, x2);
        for (int half = 0; half < 2; ++half) {
            const int mb = m0 + 13 * half;
            u32x4 raw[13];
#pragma unroll
            for (int i = 0; i < 13; ++i) { raw[i] = (u32x4){0u, 0u, 0u, 0u}; if (mb + i < M) raw[i] = *(const u32x4*)(colp + (size_t)(mb + i) * SM_NP); }
#pragma unroll
            for (int i = 0; i < 13; ++i) {
                const int m = mb + i;
                if (((m & (SEQ - 1)) == 0)) {
#pragma unroll
                    for (int e = 0; e < 8; ++e) { x0[e] = 0.f; x1[e] = 0.f; x2[e] = 0.f; }
                }
                unpack8(raw[i], x3);
                float v[8];
#pragma unroll
                for (int e = 0; e < 8; ++e) v[e] = siluf_(bb[e] + w[0][e] * x0[e] + w[1][e] * x1[e] + w[2][e] * x2[e] + w[3][e] * x3[e]);
                if (m < M) *(u32x4*)(colp + (size_t)m * SM_NP) = pack8(v);
#pragma unroll
                for (int e = 0; e < 8; ++e) { x0[e] = x1[e]; x1[e] = x2[e]; x2[e] = x3[e]; }
            }
        }
    }
}

constexpr int SST = 136;
__device__ __forceinline__ void ssd_job(const Params& P, int l, int b, int h, unsigned char* lds) {
    const int tid = ltid(), wave = __builtin_amdgcn_readfirstlane(tid >> 6);
    bf16_t* Cs = (bf16_t*)lds; bf16_t* Bs = Cs + 128 * SST; bf16_t* BsT = Bs + 128 * SST; bf16_t* XT = BsT + 128 * SST; bf16_t* Sb = XT + 64 * SST;
    float* dtv = (float*)(Sb + 64 * SST); float* acum = dtv + 128; float* scv = acum + 128; float* eav = scv + 128; float* tmpf = eav + 128;
    const bf16_t* Psm = (const bf16_t*)(P.ws + OFF_PSM); bf16_t* Yss = (bf16_t*)(P.ws + OFF_YM2);
    const int g = h >> 3;
    const float A_h = -__expf(P.in[I_ALOG][l * 16 + h]); const float Dh = P.in[I_M2D][l * 16 + h]; const float dtb = P.in[I_DTB][l * 16 + h];
    const size_t rowbase = (size_t)b * SEQ;
    int kind_o, q_o, seg_o;
    if (tid < 96) { kind_o = 0; q_o = tid / 12; seg_o = tid % 12; }
    else if (tid < 288) { kind_o = 1; q_o = (tid - 96) / 12; seg_o = (tid - 96) % 12; }
    else if (tid < 480) { kind_o = 2; q_o = (tid - 288) / 12; seg_o = (tid - 288) % 12; }
    else { kind_o = 3; q_o = 0; seg_o = 0; }
    const int ch = (kind_o == 1) ? (1024 + 128 * g + 8 * q_o) : (kind_o == 2) ? (1280 + 128 * g + 8 * q_o) : (64 * h + 8 * q_o);
    const int l0_o = 11 * seg_o, nrows_o = (kind_o == 3) ? 0 : ((128 - l0_o) < 11 ? (128 - l0_o) : 11);
    const bf16_t* srcb = Psm + rowbase * SM_NP + 2560 + ch;
    u32x4 raw[11]; float dtraw = 0.f;
#define SSD_ISSUE(cc) do { const int tb_ = (cc) * 128; \
        _Pragma("unroll") for (int i = 0; i < 11; ++i) { const int rr_ = (l0_o + i) < 127 ? (l0_o + i) : 127; raw[i] = *(const u32x4*)(srcb + (size_t)(tb_ + rr_) * SM_NP); } \
        if (tid < 128) dtraw = bf2f(((const bf16_t*)(P.ws + OFF_DT))[(rowbase + (cc) * 128 + tid) * 16 + h]); } while (0)
    SSD_ISSUE(0);
    __syncthreads();
    for (int i = tid; i < 64 * SST; i += 512) Sb[i] = 0;
    f32x16 Sacc = {};
    for (int c = 0; c < 16; ++c) {
        const int t0 = c * 128;
        LBAR();
        int tidc = tid; asm volatile("" : "+v"(tidc));
        const int lane = tidc & 63, r32 = lane & 31, hi = lane >> 5;
        int kind, q, seg;
        if (tidc < 96) { kind = 0; q = tidc / 12; seg = tidc % 12; }
        else if (tidc < 288) { kind = 1; q = (tidc - 96) / 12; seg = (tidc - 96) % 12; }
        else if (tidc < 480) { kind = 2; q = (tidc - 288) / 12; seg = (tidc - 288) % 12; }
        else { kind = 3; q = 0; seg = 0; }
        const int l0 = 11 * seg, nrows = (kind == 3) ? 0 : ((128 - l0) < 11 ? (128 - l0) : 11);
        if (kind < 3) {
#pragma unroll
            for (int i = 0; i < 11; ++i) {
                if (i < nrows) {
                    const int ll = l0 + i;
                    const u32x4 pk = raw[i];
                    if (kind == 0) {
#pragma unroll
                        for (int e = 0; e < 8; ++e) XT[(8 * q + e) * SST + ll] = (bf16_t)((e & 1) ? (pk[e >> 1] >> 16) : (pk[e >> 1] & 0xffffu));
                    } else if (kind == 1) {
                        *(u32x4*)(Bs + ll * SST + 8 * q) = pk;
#pragma unroll
                        for (int e = 0; e < 8; ++e) BsT[(8 * q + e) * SST + ll] = (bf16_t)((e & 1) ? (pk[e >> 1] >> 16) : (pk[e >> 1] & 0xffffu));
                    } else {
                        *(u32x4*)(Cs + ll * SST + 8 * q) = pk;
                    }
                }
            }
        }
        float a_inc = 0.f, dt_l = 0.f;
        if (tidc < 128) {
            dt_l = softplusf_(dtraw + dtb);
            float a = dt_l * A_h;
#pragma unroll
            for (int o = 1; o < 64; o <<= 1) { const float t = __shfl_up(a, o); if (lane >= o) a += t; }
            a_inc = a;
            if (tidc == 63) tmpf[0] = a;
        }
        if (c + 1 < 16) SSD_ISSUE(c + 1);
        LBAR();
        if (tidc < 128) { if (tidc >= 64) a_inc += tmpf[0]; acum[tidc] = a_inc; dtv[tidc] = dt_l; eav[tidc] = __expf(a_inc); }
        LBAR();
        const float atot = acum[127];
        if (tidc < 128) scv[tidc] = dt_l * __expf(atot - a_inc);
        f32x16 cb0 = {}, cb1 = {};
        const int tA = wave, trA = (int)((0x3333222110ull >> (4 * tA)) & 15), tcA = (int)((0x3210210100ull >> (4 * tA)) & 15);
        const int trB = 3, tcB = 2 + wave;
        {
#pragma unroll
            for (int k0 = 0; k0 < 128; k0 += 16) {
                const bf16x8 a = *(const bf16x8*)(Cs + (32 * trA + r32) * SST + k0 + 8 * hi);
                const bf16x8 bq = *(const bf16x8*)(Bs + (32 * tcA + r32) * SST + k0 + 8 * hi);
                cb0 = __builtin_amdgcn_mfma_f32_32x32x16_bf16(a, bq, cb0, 0, 0, 0);
            }
            if (wave < 2) {
#pragma unroll
                for (int k0 = 0; k0 < 128; k0 += 16) {
                    const bf16x8 a = *(const bf16x8*)(Cs + (32 * trB + r32) * SST + k0 + 8 * hi);
                    const bf16x8 bq = *(const bf16x8*)(Bs + (32 * tcB + r32) * SST + k0 + 8 * hi);
                    cb1 = __builtin_amdgcn_mfma_f32_32x32x16_bf16(a, bq, cb1, 0, 0, 0);
                }
            }
        }
        LBAR();
        {
#pragma unroll
            for (int r = 0; r < 16; ++r) {
                { const int ll = 32 * trA + crow(r, hi), sx = 32 * tcA + r32; const float v = (sx <= ll) ? cb0[r] * __expf(acum[ll] - acum[sx]) * dtv[sx] : 0.f; Bs[ll * SST + sx] = (bf16_t)f2bf(v); }
                if (wave < 2) { const int ll = 32 * trB + crow(r, hi), sx = 32 * tcB + r32; const float v = (sx <= ll) ? cb1[r] * __expf(acum[ll] - acum[sx]) * dtv[sx] : 0.f; Bs[ll * SST + sx] = (bf16_t)f2bf(v); }
            }
        }
        LBAR();
        {
            const int tr = wave >> 1, tc = wave & 1;
            f32x16 y2 = {}, y3 = {};
#pragma unroll 4
            for (int k0 = 0; k0 < 32 * (tr + 1); k0 += 16) {
                const bf16x8 a = *(const bf16x8*)(Bs + (32 * tr + r32) * SST + k0 + 8 * hi);
                const bf16x8 bq = *(const bf16x8*)(XT + (32 * tc + r32) * SST + k0 + 8 * hi);
                y2 = __builtin_amdgcn_mfma_f32_32x32x16_bf16(a, bq, y2, 0, 0, 0);
            }
#pragma unroll
            for (int k0 = 0; k0 < 128; k0 += 16) {
                const bf16x8 a = *(const bf16x8*)(Cs + (32 * tr + r32) * SST + k0 + 8 * hi);
                const bf16x8 bq = *(const bf16x8*)(Sb + (32 * tc + r32) * SST + k0 + 8 * hi);
                y3 = __builtin_amdgcn_mfma_f32_32x32x16_bf16(a, bq, y3, 0, 0, 0);
            }
            const int p = 32 * tc + r32;
#pragma unroll
            for (int r = 0; r < 16; ++r) {
                const int ll = 32 * tr + crow(r, hi);
                const float y = y2[r] + eav[ll] * y3[r] + Dh * bf2f(XT[p * SST + ll]);
                Yss[(rowbase + t0 + ll) * 1024 + 64 * h + p] = (bf16_t)f2bf(y);
            }
        }
        const int pt = wave >> 2, nt = wave & 3;
        {
            const float dtot = __expf(atot);
#pragma unroll
            for (int r = 0; r < 16; ++r) Sacc[r] *= dtot;
#pragma unroll
            for (int k0 = 0; k0 < 128; k0 += 16) {
                const u32x4 aw = *(const u32x4*)(XT + (32 * pt + r32) * SST + k0 + 8 * hi);
                float af[8]; unpack8(aw, af);
                const f32x4 s0 = *(const f32x4*)(scv + k0 + 8 * hi), s1 = *(const f32x4*)(scv + k0 + 8 * hi + 4);
                af[0] *= s0[0]; af[1] *= s0[1]; af[2] *= s0[2]; af[3] *= s0[3]; af[4] *= s1[0]; af[5] *= s1[1]; af[6] *= s1[2]; af[7] *= s1[3];
                const u32x4 a2 = pack8(af);
                const bf16x8 a = __builtin_bit_cast(bf16x8, a2);
                const bf16x8 bq = *(const bf16x8*)(BsT + (32 * nt + r32) * SST + k0 + 8 * hi);
                Sacc = __builtin_amdgcn_mfma_f32_32x32x16_bf16(a, bq, Sacc, 0, 0, 0);
            }
        }
        LBAR();
#pragma unroll
        for (int r = 0; r < 16; ++r) Sb[(32 * pt + crow(r, hi)) * SST + 32 * nt + r32] = (bf16_t)f2bf(Sacc[r]);
    }
#undef SSD_ISSUE
    __syncthreads();
}

__device__ __forceinline__ void phase_m2_post(const Params& P, int l) {
    const int tid = ltid(), lane = tid & 63, wave = tid >> 6;
    const int gw = blockIdx.x * 8 + wave, NGW = gridDim.x * 8;
    const bf16_t* Psm = (const bf16_t*)(P.ws + OFF_PSM); bf16_t* Y = (bf16_t*)(P.ws + OFF_YM2);
    const float* ng = P.in[I_M2NG] + l * 1024;
    for (int it = gw; it < M * 2; it += NGW) {
        const int m = it >> 1, g = it & 1, ch = 512 * g + 8 * lane;
        const u32x4 yw = *(const u32x4*)(Y + (size_t)m * 1024 + ch), zw = *(const u32x4*)(Psm + (size_t)m * SM_NP + 1536 + ch);
        float y[8], z[8]; unpack8(yw, y); unpack8(zw, z);
        float ss = 0.f;
#pragma unroll
        for (int i = 0; i < 8; ++i) { y[i] *= siluf_(z[i]); ss += y[i] * y[i]; }
        const float rstd = 1.0f / sqrtf(wave_sum(ss) * (1.f / 512.f) + 1e-6f);
#pragma unroll
        for (int i = 0; i < 8; ++i) y[i] = y[i] * rstd * ng[ch + i];
        *(u32x4*)(Y + (size_t)m * 1024 + ch) = pack8(y);
    }
}

__device__ __forceinline__ void phase_ffn_fixup(const Params& P, int l) {
    const bf16_t* Ue = (const bf16_t*)(P.ws + OFF_UE); bf16_t* GU = (bf16_t*)(P.ws + OFF_GU);
    const float* cw = P.in[I_FCW] + (size_t)l * 3 * UP_N; const float* cb = P.in[I_FCB] + (size_t)l * UP_N;
    const int total = (M / 64) * 352, stride = gridDim.x * 512;
    for (int it = blockIdx.x * 512 + ltid(); it < total; it += stride) {
        const int grp = it / 352, j = (it - grp * 352) * 8; const bool first = (grp & 31) == 0;
        const bf16_t* e = Ue + (size_t)grp * 4 * UP_N; const bf16_t* p = Ue + (size_t)(first ? grp : grp - 1) * 4 * UP_N;
        float g_m2[8], g_m1[8], g_0[8], g_1[8], v_m2[8], v_m1[8], v_0[8], v_1[8];
        unpack8(*(const u32x4*)(p + 2 * UP_N + j), g_m2); unpack8(*(const u32x4*)(p + 3 * UP_N + j), g_m1); unpack8(*(const u32x4*)(e + j), g_0); unpack8(*(const u32x4*)(e + UP_N + j), g_1);
        unpack8(*(const u32x4*)(p + 2 * UP_N + DFF + j), v_m2); unpack8(*(const u32x4*)(p + 3 * UP_N + DFF + j), v_m1); unpack8(*(const u32x4*)(e + DFF + j), v_0); unpack8(*(const u32x4*)(e + UP_N + DFF + j), v_1);
        float o0[8], o1[8];
#pragma unroll
        for (int i = 0; i < 8; ++i) {
            const float zg2 = first ? 0.f : g_m2[i], zg1 = first ? 0.f : g_m1[i], zv2 = first ? 0.f : v_m2[i], zv1 = first ? 0.f : v_m1[i];
            const float wg0 = cw[j + i], wg1 = cw[UP_N + j + i], wg2 = cw[2 * UP_N + j + i], bg = cb[j + i];
            const float wv0 = cw[DFF + j + i], wv1 = cw[UP_N + DFF + j + i], wv2 = cw[2 * UP_N + DFF + j + i], bv = cb[DFF + j + i];
            o0[i] = siluf_(bg + wg0 * zg2 + wg1 * zg1 + wg2 * g_0[i]) * (bv + wv0 * zv2 + wv1 * zv1 + wv2 * v_0[i]);
            o1[i] = siluf_(bg + wg0 * zg1 + wg1 * g_0[i] + wg2 * g_1[i]) * (bv + wv0 * zv1 + wv1 * v_0[i] + wv2 * v_1[i]);
        }
        *(u32x4*)(GU + (size_t)(64 * grp) * DFF + j) = pack8(o0); *(u32x4*)(GU + (size_t)(64 * grp + 1) * DFF + j) = pack8(o1);
    }
}

__device__ __forceinline__ void run_gemm(unsigned char* lds, const bf16_t* A, const bf16_t* Bt, int Mrows, int N, int K, const EpiX& E) {
    pg8::Gemm g{A, Bt, Mrows, N, K}; pg8::StaticOrder S; S.init(Mrows, N, (int)gridDim.x, (int)blockIdx.x);
    pg8::gemm_phase<EpiX, pg8::StaticOrder, true, true>((LAS unsigned char*)lds, g, S, E);
    __syncthreads();
}

__global__ void __launch_bounds__(512, 2) fwd_megakernel(Params P) {
    extern __shared__ __attribute__((aligned(16))) unsigned char lds[];
    cg::grid_group grid = cg::this_grid();
    unsigned char* ws = P.ws;
    volatile LAS unsigned* bst = (volatile LAS unsigned*)((LAS unsigned char*)lds + (LDS_BYTES - 64));
    if (threadIdx.x < 2) bst[threadIdx.x] = 0u;
    __syncthreads();
    XcdBarrier xbar = xcd_barrier_post((unsigned*)(ws + OFF_BAR), bst);
#define GSYNC() xcd_barrier(xbar)
    const float* mod = (const float*)(ws + OFF_MOD);
    bf16_t* XN = (bf16_t*)(ws + OFF_XN);
    phase_mod(P, lds);
    for (int l = 0; l < NL; ++l) {
        const float* ml = mod + (size_t)l * 8 * 6144;
        const float* xin = (l == 0) ? P.in[I_X] : nullptr;
        bf16_t* XB = (bf16_t*)P.out + (size_t)M * 1024;
        phase_convert(P, l, lds);
#if (PROBE_MASK & 64)
        phase_convert(P, l, lds);
#endif
        if (P.ws == nullptr) grid.sync();
        if (l == 0) GSYNC();
        phase_norm_mod(xin, XB, P.in[I_N1G] + l * 1024, ml + 0 * 1024, ml + 1 * 1024, XN);
        GSYNC();
        for (int step = 0; step < 18; ++step) {
            EpiX E{}; const bf16_t* A = XN; const bf16_t* Bt = nullptr; int N = 1024, K = 1024; bool do_gemm = true; bool sync_after = true;
            switch (step) {
                case 0: Bt = (const bf16_t*)(ws + OFF_WRW); N = PRW_LD; E.mode = 0; E.Ob = (bf16_t*)(ws + OFF_PRW); E.ldc = PRW_LD; break;
                case 1: do_gemm = false; phase_rwkv_pre(P, l, lds);
#if (PROBE_MASK & 1)
                        GSYNC(); phase_rwkv_pre(P, l, lds);
#endif
                        break;
                case 2: do_gemm = false; phase_scan(P, lds);
#if (PROBE_MASK & 2)
                        GSYNC(); phase_scan(P, lds);
#endif
                        break;
                case 3: do_gemm = false; phase_rwkv_post(P, l);
#if (PROBE_MASK & 256)
                        phase_rwkv_post(P, l);
#endif
                        break;
                case 4: Bt = (const bf16_t*)(ws + OFF_WSM); N = SM_NP; E.mode = 0; E.Ob = (bf16_t*)(ws + OFF_PSM); E.ldc = SM_NP; break;
                case 5: do_gemm = false; phase_xbc_conv(P, l, xbar); GSYNC();
                        if ((blockIdx.x & 1) == 0) { for (int job = blockIdx.x >> 1; job < 128; job += (gridDim.x + 1) >> 1) ssd_job(P, l, job >> 4, job & 15, lds); }
                        else phase_attn(P, lds);
                        break;
                case 6: do_gemm = false; phase_m2_post(P, l);
                        break;
                case 7: Bt = (const bf16_t*)(ws + OFF_WG); N = 3072; E.mode = 1; E.Ob = (bf16_t*)(ws + OFF_GS); E.ldc = 1024; break;
                case 8: case 10: case 12: { const int i = (step - 8) >> 1; sync_after = (i == 2);
                        A = (const bf16_t*)(ws + (i == 0 ? OFF_YRW : i == 1 ? OFF_YSB : OFF_YM2));
                        Bt = (const bf16_t*)(ws + (i == 0 ? OFF_WRWO : i == 1 ? OFF_WSBO : OFF_WM2O)); K = (i == 2) ? 1024 : 512;
                        E.mode = 2 + i; E.Gs = (const bf16_t*)(ws + OFF_GS) + (size_t)i * M * 1024; E.Ob = (bf16_t*)(ws + OFF_MB); E.ldc = 1024; } break;
                case 9: case 11: do_gemm = false; sync_after = false; break;
                case 13: A = (const bf16_t*)(ws + OFF_MB); Bt = (const bf16_t*)(ws + OFF_WOUT); E.mode = 5; E.xin = xin; E.xinb = XB; E.xoutb = XB; E.gate = ml + 2 * 1024; break;
                case 14: do_gemm = false; phase_norm_mod(nullptr, XB, P.in[I_N2G] + l * 1024, ml + 3 * 1024, ml + 4 * 1024, XN); break;
                case 15: Bt = (const bf16_t*)(ws + OFF_WUP); N = UP_N; E.mode = 6; E.Ob = (bf16_t*)(ws + OFF_GU); E.ldc = DFF; E.Ue = (bf16_t*)(ws + OFF_UE);
                         E.cw = P.in[I_FCW] + (size_t)l * 3 * UP_N; E.cb = P.in[I_FCB] + (size_t)l * UP_N; break;
                case 16: do_gemm = false; phase_ffn_fixup(P, l); break;
                case 17: A = (const bf16_t*)(ws + OFF_GU); Bt = (const bf16_t*)(ws + OFF_WDOWN); K = DFF; E.mode = 5; E.xin = nullptr; E.xinb = XB; E.xoutb = XB; E.gate = ml + 5 * 1024; break;
            }
            int nrep = 1;
#if (PROBE_MASK & 512)
            if (step == 0 || step == 4) nrep = 2;
#endif
#if (PROBE_MASK & 1024)
            if (step == 15) nrep = 2;
#endif
#if (PROBE_MASK & 2048)
            if (step == 7) nrep = 2;
#endif
#if (PROBE_MASK & 4096)
            if (step == 8) nrep = 2;
#endif
#if (PROBE_MASK & 8192)
            if (step == 13 && l == 0) nrep = 2;
#endif
            if (do_gemm) for (int rep = 0; rep < nrep; ++rep) run_gemm(lds, A, Bt, M, N, K, E);
            if (sync_after) GSYNC();
#if (PROBE_MASK & 32)
            if (sync_after) { GSYNC(); GSYNC(); GSYNC(); GSYNC(); }
#endif
        }
    }
    phase_final_norm((const bf16_t*)P.out + (size_t)M * 1024, P.out, P.in[I_FNG], xbar);
}

extern "C" void kernel_launch(void* const* d_in, const int* in_sizes, int n_in, void* d_out, int out_size, void* d_ws, size_t ws_size, hipStream_t stream) {
    static int grid_blocks = 0;
    if (grid_blocks == 0) {
        if (n_in != 33 || ws_size < WS_ASSUMED) { fprintf(stderr, "kernel_launch: unexpected n_in %d / ws_size %zu\n", n_in, ws_size); grid_blocks = -1; return; }
        int dev = 0, cus = 0, per_cu = 0;
        hipGetDevice(&dev);
        hipDeviceGetAttribute(&cus, hipDeviceAttributeMultiprocessorCount, dev);
        hipFuncSetAttribute((const void*)fwd_megakernel, hipFuncAttributeMaxDynamicSharedMemorySize, LDS_BYTES);
        hipOccupancyMaxActiveBlocksPerMultiprocessor(&per_cu, (const void*)fwd_megakernel, 512, LDS_BYTES);
        if (per_cu < 1) { fprintf(stderr, "kernel_launch: occupancy query says %d blocks/CU\n", per_cu); per_cu = 1; }
        grid_blocks = cus * 1;
        (void)hipGetLastError();
    }
    if (grid_blocks < 0) return;
    Params p{};
    for (int i = 0; i < 33; ++i) p.in[i] = (const float*)d_in[i];
    p.out = (float*)d_out; p.ws = (unsigned char*)d_ws;
    if (hipMemsetAsync((char*)d_ws + OFF_BAR, 0, XCD_BAR_WORDS * 4, stream) != hipSuccess) { fprintf(stderr, "memset failed\n"); return; }
    void* args[] = {&p};
    hipError_t e = hipLaunchCooperativeKernel((const void*)fwd_megakernel, dim3(grid_blocks), dim3(512), args, LDS_BYTES, stream);
    if (e != hipSuccess) fprintf(stderr, "cooperative launch failed: %s (grid %d)\n", hipGetErrorString(e), grid_blocks);
}
```

```cpp
#include <hip/hip_runtime.h>
#include <hip/hip_cooperative_groups.h>
#include <cstdio>
#include <cstdint>
namespace cg = cooperative_groups;
#ifndef PROBE_MASK
#define PROBE_MASK 0
#endif
namespace pg8 {
#define PG8_LAS __attribute__((address_space(3)))
typedef unsigned short bf16_t;
typedef short bf16x8 __attribute__((ext_vector_type(8)));
typedef float f32x4 __attribute__((ext_vector_type(4)));
typedef unsigned u32x4 __attribute__((ext_vector_type(4)));
constexpr int BM = 256, BK = 64, HALF = 128, HTB = HALF * BK * 2  , STAGE_BYTES = 8 * HTB, NXCD = 8, WGM = 8;

__host__ __device__ __forceinline__ int lds_byte(int r, int c) { const int st = (r >> 4) * 2 + (c >> 5), rr = r & 15, cc = c & 31, ob = rr * 64 + cc * 2; return st * 1024 + (ob ^ (((ob >> 9) & 1) << 5)); }
__host__ __device__ __forceinline__ void stage_rc(int b, int& R, int& C) { const int st = b / 1024, sb = b % 1024, swz = sb ^ (((sb >> 9) & 1) << 5); R = (st >> 1) * 16 + swz / 64; C = (st & 1) * 32 + (swz % 64) / 2; }
__host__ __device__ __forceinline__ int perm32(int rho) { const int n = rho >> 4, i = rho & 15; return 8 * (i >> 2) + 4 * n + (i & 3); }

struct Unit { int pm, pn; };
struct Gemm { const bf16_t* A; const bf16_t* Bt; int M, N, K; };

struct StaticOrder {
    int nM, nN, nwg, G, c;
    __host__ __device__ void init(int M, int N, int G_, int c_) { nM = M / BM; nN = N / BM; nwg = nM * nN; G = G_; c = c_; }
    __host__ __device__ bool next(int i, Unit& u) const {
        const long L = (long)i * G + c; if (L >= nwg) return false;
        int wgid = (int)L; { const int q = nwg / NXCD, r = nwg % NXCD, xcd = wgid % NXCD, off = wgid / NXCD; wgid = (xcd < r ? xcd * (q + 1) : r * (q + 1) + (xcd - r) * q) + off; }
        const int nig = WGM * nN, gid = wgid / nig, fm = gid * WGM, gsz = (nM - fm) < WGM ? (nM - fm) : WGM;
        u.pm = fm + ((wgid % nig) % gsz); u.pn = (wgid % nig) / gsz; return true;
    }
    __device__ __forceinline__ void a_ready(const Unit&) const {}
    __device__ __forceinline__ void done(const Unit&) const {}
};

__device__ __forceinline__ unsigned cvt_pk_bf16(float lo, float hi) { unsigned r; asm volatile("v_cvt_pk_bf16_f32 %0, %1, %2" : "=v"(r) : "v"(lo), "v"(hi)); return r; }
typedef float f32x2 __attribute__((ext_vector_type(2)));
template <class Epi, class Sched, bool ALIGN_EPI = false, bool SP2 = false>
__device__ __forceinline__ void gemm_phase(PG8_LAS unsigned char* lds, const Gemm g, const Sched& S, const Epi& E) {
    int tid_l = threadIdx.x; asm volatile("" : "+v"(tid_l)); const int tid = tid_l, wid = __builtin_amdgcn_readfirstlane(tid >> 6), lane = tid & 63, wr = wid >> 2, wc = wid & 3, fr = lane & 15, fq = lane >> 4;
    const int K = g.K, nt = K / BK;
    unsigned voffA[2], voffB[2];
#pragma unroll
    for (int i = 0; i < 2; ++i) { int R, C; stage_rc(tid * 16 + i * 8192, R, C); const int Rb = Epi::PERM ? ((R & ~31) + perm32(R & 31)) : R;
        voffA[i] = (unsigned)(R * K + C) * 2u; voffB[i] = (unsigned)(Rb * K + C) * 2u; }
    const size_t kstep = (size_t)(BK * 2);
    const size_t hstep = (size_t)HALF * K * 2;
    const size_t tstep = 2 * hstep;
    const unsigned ldsw = (unsigned)wid * 1024u;
    const int aoff = lds_byte(wr * 64 + fr, fq * 8), boff = lds_byte(wc * 32 + fr, fq * 8);
#define PG8_SA(b, h) (((b) * 2 + (h)) * HTB)
#define PG8_SB(b, h) ((4 + (b) * 2 + (h)) * HTB)
#define PG8_STAGE(bufoff, gbase, voff) do { _Pragma("unroll") for (int _i = 0; _i < 2; ++_i) \
        __builtin_amdgcn_global_load_lds((const unsigned*)((const char*)(gbase) + (voff)[_i]), (PG8_LAS unsigned*)(lds + (bufoff) + ldsw + _i * 8192), 16, 0, 0); } while (0)
#define PG8_LDA(dst, b, h) do { _Pragma("unroll") for (int m = 0; m < 4; ++m) _Pragma("unroll") for (int k = 0; k < 2; ++k) dst[m][k] = *(const PG8_LAS bf16x8*)(lds + PG8_SA(b, h) + aoff + m * 2048 + k * 1024); } while (0)
#define PG8_LDB(dst, b, h) do { _Pragma("unroll") for (int n = 0; n < 2; ++n) _Pragma("unroll") for (int k = 0; k < 2; ++k) dst[n][k] = *(const PG8_LAS bf16x8*)(lds + PG8_SB(b, h) + boff + n * 2048 + k * 1024); } while (0)
#define PG8_MMA(ai, bj, At, Bt) do { __builtin_amdgcn_s_setprio(1); _Pragma("unroll") for (int m = 0; m < 4; ++m) _Pragma("unroll") for (int n = 0; n < 2; ++n) _Pragma("unroll") for (int k = 0; k < 2; ++k) \
        acc[ai][bj][m][n] = __builtin_amdgcn_mfma_f32_16x16x32_bf16(Bt[n][k], At[m][k], acc[ai][bj][m][n], 0, 0, 0); __builtin_amdgcn_s_setprio(0); } while (0)
#define PG8_WAIT_V(n) asm volatile("s_waitcnt vmcnt(" #n ")" ::: "memory")
#define PG8_WAIT_L(n) asm volatile("s_waitcnt lgkmcnt(" #n ")" ::: "memory")
#define PG8_BAR __builtin_amdgcn_s_barrier()
#define PG8_SCHED __builtin_amdgcn_sched_barrier(0)
    Unit cur, nxt; int ui = 0;
    if (!S.next(0, cur)) return;
    f32x4 acc[2][2][4][2];
#pragma unroll
    for (int a = 0; a < 2; ++a)
#pragma unroll
        for (int b = 0; b < 2; ++b)
#pragma unroll
            for (int m = 0; m < 4; ++m)
#pragma unroll
                for (int n = 0; n < 2; ++n) acc[a][b][m][n] = (f32x4){0.f, 0.f, 0.f, 0.f};
    bf16x8 At[4][2], B0[2][2], B1[2][2];
    const char* cA = (const char*)g.A + (size_t)cur.pm * tstep; const char* cB = (const char*)g.Bt + (size_t)cur.pn * tstep;
    S.a_ready(cur);
    if constexpr (SP2) {
        PG8_STAGE(PG8_SB(0, 0), cB, voffB); PG8_STAGE(PG8_SB(0, 1), cB + hstep, voffB); PG8_STAGE(PG8_SA(0, 0), cA, voffA); PG8_STAGE(PG8_SA(0, 1), cA + hstep, voffA);
        if (wr == 1) PG8_BAR;
        PG8_WAIT_V(2); PG8_BAR;
        PG8_STAGE(PG8_SB(1, 0), cB + kstep, voffB); PG8_STAGE(PG8_SA(1, 0), cA + kstep, voffA); PG8_STAGE(PG8_SB(1, 1), cB + hstep + kstep, voffB);
        PG8_WAIT_V(6); PG8_BAR;
    } else {
        PG8_STAGE(PG8_SB(0, 0), cB, voffB); PG8_STAGE(PG8_SA(0, 0), cA, voffA); PG8_STAGE(PG8_SB(0, 1), cB + hstep, voffB); PG8_STAGE(PG8_SA(0, 1), cA + hstep, voffA);
        if (wr == 1) PG8_BAR;
        PG8_WAIT_V(4); PG8_BAR;
        PG8_STAGE(PG8_SB(1, 0), cB + kstep, voffB); PG8_STAGE(PG8_SA(1, 0), cA + kstep, voffA); PG8_STAGE(PG8_SB(1, 1), cB + hstep + kstep, voffB);
        PG8_WAIT_V(6); PG8_BAR;
    }
    for (;;) {
        const bool has_next = S.next(ui + 1, nxt);
        const char* nA = has_next ? (const char*)g.A + (size_t)nxt.pm * tstep : cA; const char* nB = has_next ? (const char*)g.Bt + (size_t)nxt.pn * tstep : cB;
        for (int t = 0; t < nt; t += 2) {
            const bool last = (t == nt - 2);
            const char* a1 = cA + (size_t)(t + 1) * kstep;
            const char* a2 = last ? nA : cA + (size_t)(t + 2) * kstep; const char* b2 = last ? nB : cB + (size_t)(t + 2) * kstep;
            const char* a3 = a2 + kstep; const char* b3 = b2 + kstep;
            if (last && has_next) S.a_ready(nxt);
            if constexpr (SP2) {
            PG8_LDB(B0, 0, 0); PG8_LDB(B1, 0, 1); PG8_SCHED; PG8_LDA(At, 0, 0); PG8_STAGE(PG8_SA(1, 1), a1 + hstep, voffA);
            PG8_WAIT_V(8); PG8_WAIT_L(0); PG8_BAR; PG8_MMA(0, 0, At, B0); PG8_MMA(0, 1, At, B1); PG8_BAR; PG8_SCHED;
            PG8_LDA(At, 0, 1); PG8_STAGE(PG8_SB(0, 0), b2, voffB); PG8_STAGE(PG8_SB(0, 1), b2 + hstep, voffB); PG8_STAGE(PG8_SA(0, 0), a2, voffA);
            PG8_WAIT_V(8); PG8_WAIT_L(0); PG8_BAR; PG8_MMA(1, 0, At, B0); PG8_MMA(1, 1, At, B1); PG8_BAR; PG8_SCHED;
            PG8_LDB(B0, 1, 0); PG8_LDB(B1, 1, 1); PG8_SCHED; PG8_LDA(At, 1, 0); PG8_STAGE(PG8_SA(0, 1), a2 + hstep, voffA);
            PG8_WAIT_V(8); PG8_WAIT_L(0); PG8_BAR; PG8_MMA(0, 0, At, B0); PG8_MMA(0, 1, At, B1); PG8_BAR; PG8_SCHED;
            PG8_LDA(At, 1, 1); PG8_STAGE(PG8_SB(1, 0), b3, voffB); PG8_STAGE(PG8_SB(1, 1), b3 + hstep, voffB); PG8_STAGE(PG8_SA(1, 0), a3, voffA);
            PG8_WAIT_V(8); PG8_WAIT_L(0); PG8_BAR; PG8_MMA(1, 0, At, B0); PG8_MMA(1, 1, At, B1); PG8_BAR; PG8_SCHED;
            } else {
            PG8_LDB(B0, 0, 0); PG8_SCHED; PG8_LDA(At, 0, 0); PG8_STAGE(PG8_SA(1, 1), a1 + hstep, voffA);
            PG8_WAIT_L(8); PG8_BAR; PG8_WAIT_L(0); PG8_MMA(0, 0, At, B0); PG8_BAR; PG8_SCHED;
            PG8_LDB(B1, 0, 1); PG8_STAGE(PG8_SB(0, 0), b2, voffB);
            PG8_BAR; PG8_WAIT_L(0); PG8_MMA(0, 1, At, B1); PG8_BAR;
            PG8_LDA(At, 0, 1); PG8_STAGE(PG8_SA(0, 0), a2, voffA);
            PG8_BAR; PG8_WAIT_L(0); PG8_MMA(1, 0, At, B0); PG8_BAR; PG8_SCHED;
            PG8_STAGE(PG8_SB(0, 1), b2 + hstep, voffB);
            PG8_WAIT_V(6); PG8_BAR; PG8_MMA(1, 1, At, B1); PG8_BAR;
            PG8_LDB(B0, 1, 0); PG8_SCHED; PG8_LDA(At, 1, 0); PG8_STAGE(PG8_SA(0, 1), a2 + hstep, voffA);
            PG8_WAIT_L(8); PG8_BAR; PG8_WAIT_L(0); PG8_MMA(0, 0, At, B0); PG8_BAR; PG8_SCHED;
            PG8_LDB(B1, 1, 1); PG8_STAGE(PG8_SB(1, 0), b3, voffB);
            PG8_BAR; PG8_WAIT_L(0); PG8_MMA(0, 1, At, B1); PG8_BAR;
            PG8_LDA(At, 1, 1); PG8_STAGE(PG8_SA(1, 0), a3, voffA);
            PG8_BAR; PG8_WAIT_L(0); PG8_MMA(1, 0, At, B0); PG8_BAR; PG8_SCHED;
            PG8_STAGE(PG8_SB(1, 1), b3 + hstep, voffB);
            PG8_WAIT_V(6); PG8_BAR; PG8_MMA(1, 1, At, B1); PG8_BAR;
            }
        }
        if constexpr (ALIGN_EPI) { if (wr == 0) PG8_BAR; }
        if constexpr (!Epi::AFTER_DRAIN) { E(acc, cur, wr, wc, fr, fq); S.done(cur); }
        if (!has_next) break;
#pragma unroll
        for (int a = 0; a < 2; ++a)
#pragma unroll
            for (int b = 0; b < 2; ++b)
#pragma unroll
                for (int m = 0; m < 4; ++m)
#pragma unroll
                    for (int n = 0; n < 2; ++n) acc[a][b][m][n] = (f32x4){0.f, 0.f, 0.f, 0.f};
        cur = nxt; cA = nA; cB = nB; ++ui;
        if constexpr (ALIGN_EPI) { if (wr == 1) PG8_BAR; }
    }
    PG8_WAIT_V(0);
    if constexpr (!ALIGN_EPI) { if (wr == 0) PG8_BAR; }
    PG8_BAR;
    if constexpr (Epi::AFTER_DRAIN) { E.fused(acc, cur, wr, wc, fr, fq, lds, wid, lane); S.done(cur); }
#undef PG8_SA
#undef PG8_SB
#undef PG8_STAGE
#undef PG8_LDA
#undef PG8_LDB
#undef PG8_MMA
#undef PG8_WAIT_V
#undef PG8_WAIT_L
#undef PG8_BAR
#undef PG8_SCHED
}
}
typedef unsigned short bf16_t;
typedef short bf16x8 __attribute__((ext_vector_type(8)));
typedef float f32x4 __attribute__((ext_vector_type(4)));
typedef float f32x16 __attribute__((ext_vector_type(16)));
typedef float f32x2 __attribute__((ext_vector_type(2)));
typedef unsigned u32x4 __attribute__((ext_vector_type(4)));
typedef unsigned u32x2 __attribute__((ext_vector_type(2)));
#define LAS __attribute__((address_space(3)))
__device__ __forceinline__ int ltid() { int t = threadIdx.x; asm volatile("" : "+v"(t)); return t; }

constexpr int M = 16384, D = 1024, SEQ = 2048, NB = 8, NL = 2;
constexpr int NIN = 8976, RW_IN = 1792, PRW_LD = 2048, SM_N = 4096, SM_NP = 4096, G_N = 3072;
constexpr int DFF = 2816, UP_N = 5632;
constexpr int LDS_BYTES = 147456;
#ifndef PROBE_MASK
#define PROBE_MASK 0
#endif

constexpr size_t OFF_MOD   = 0;
constexpr size_t OFF_BAR   = 524288;
constexpr size_t OFF_LORA  = 589824;
constexpr size_t OFF_WDOWN = 1048576;
constexpr size_t OFF_WRW   = OFF_WDOWN + (size_t)1024 * 2816 * 2;
constexpr size_t OFF_WSM   = OFF_WRW + (size_t)2048 * 1024 * 2;
constexpr size_t OFF_WG    = OFF_WSM + (size_t)4096 * 1024 * 2;
constexpr size_t OFF_WRWO  = OFF_WG + (size_t)3072 * 1024 * 2;
constexpr size_t OFF_WSBO  = OFF_WRWO + (size_t)1024 * 512 * 2;
constexpr size_t OFF_WM2O  = OFF_WSBO + (size_t)1024 * 512 * 2;
constexpr size_t OFF_WOUT  = OFF_WM2O + (size_t)1024 * 1024 * 2;
constexpr size_t OFF_WUP   = OFF_WOUT + (size_t)1024 * 1024 * 2;
constexpr size_t OFF_XN    = OFF_WUP + (size_t)5632 * 1024 * 2;
constexpr size_t OFF_R     = OFF_XN + (size_t)M * 1024 * 2;
constexpr size_t SZ16 = (size_t)M * 512 * 2;
constexpr size_t OFF_PRW  = OFF_R;
constexpr size_t OFF_SR   = OFF_PRW + (size_t)M * PRW_LD * 2;
constexpr size_t OFF_SK   = OFF_SR + SZ16;
constexpr size_t OFF_SV   = OFF_SK + SZ16;
constexpr size_t OFF_SKK  = OFF_SV + SZ16;
constexpr size_t OFF_SKKA = OFF_SKK + SZ16;
constexpr size_t OFF_SW   = OFF_SKKA + SZ16;
constexpr size_t OFF_SG   = OFF_SW + 2 * SZ16;
constexpr size_t OFF_YRAW = OFF_R + SZ16;
constexpr size_t END_RWKV = OFF_SG + SZ16;
constexpr size_t OFF_YRW  = OFF_R;
constexpr size_t OFF_YSB  = OFF_YRW + SZ16;
constexpr size_t OFF_YM2  = OFF_YSB + SZ16;
constexpr size_t OFF_PSM  = OFF_YM2 + 2 * SZ16;
constexpr size_t END_SM   = OFF_PSM + (size_t)M * SM_NP * 2;
constexpr size_t OFF_DT   = OFF_R + 201326592;
static_assert(END_RWKV <= OFF_DT && END_SM <= OFF_DT && OFF_DT + (size_t)M * 32 <= 294125568, "dt buffer");
constexpr size_t OFF_GS   = OFF_PSM;
constexpr size_t OFF_MB   = OFF_GS + 6 * SZ16;
constexpr size_t WS_ASSUMED = 294125568;
constexpr size_t OFF_GU   = OFF_R + 33554432;
constexpr size_t OFF_UE   = OFF_GU + (size_t)M * 2816 * 2;
static_assert(END_RWKV <= WS_ASSUMED && END_SM <= WS_ASSUMED && OFF_MB + 2 * SZ16 <= WS_ASSUMED, "ws map");
static_assert(OFF_UE + (size_t)(M / 64) * 4 * 5632 * 2 <= WS_ASSUMED, "GU/UE");

struct Params {
    const float* in[33];
    float* out;
    unsigned char* ws;
};
enum { I_X = 0, I_C, I_ADAW, I_ADAB, I_N1G, I_N2G, I_WIN, I_MU, I_W0, I_W2, I_A0, I_A2, I_G2, I_KK, I_KA, I_RK, I_LNG, I_LNB,
       I_RWWO, I_SBWO, I_CONVW, I_CONVB, I_DTB, I_ALOG, I_M2D, I_M2NG, I_M2WO, I_WOUT, I_FUP, I_FCW, I_FCB, I_FDOWN, I_FNG };

__device__ __forceinline__ float bf2f(unsigned v) { return __uint_as_float(v << 16); }
__device__ __forceinline__ unsigned f2bf(float f) { unsigned u = __float_as_uint(f); return (u + 0x7fffu + ((u >> 16) & 1u)) >> 16; }
typedef __bf16 bf16x2_t __attribute__((ext_vector_type(2)));
__device__ __forceinline__ unsigned pk2(float lo, float hi) { const f32x2 v = {lo, hi}; const bf16x2_t b = __builtin_convertvector(v, bf16x2_t); return __builtin_bit_cast(unsigned, b); }
__device__ __forceinline__ float sigmoidf_(float x) { return __builtin_amdgcn_rcpf(1.0f + __expf(-x)); }
__device__ __forceinline__ float siluf_(float x) { return x * __builtin_amdgcn_rcpf(1.0f + __expf(-x)); }
__device__ __forceinline__ float softplusf_(float x) { return fmaxf(x, 0.f) + __logf(1.0f + __expf(-fabsf(x))); }
__device__ __forceinline__ float wave_sum(float v) {
#pragma unroll
    for (int o = 1; o < 64; o <<= 1) v += __shfl_xor(v, o);
    return v;
}
__device__ __forceinline__ void unpack8(u32x4 w, float* f) {
    f[0] = bf2f(w.x & 0xffffu); f[1] = bf2f(w.x >> 16); f[2] = bf2f(w.y & 0xffffu); f[3] = bf2f(w.y >> 16);
    f[4] = bf2f(w.z & 0xffffu); f[5] = bf2f(w.z >> 16); f[6] = bf2f(w.w & 0xffffu); f[7] = bf2f(w.w >> 16);
}
__device__ __forceinline__ u32x4 pack8(const float* f) {
    u32x4 w; w.x = pk2(f[0], f[1]); w.y = pk2(f[2], f[3]); w.z = pk2(f[4], f[5]); w.w = pk2(f[6], f[7]); return w;
}

#define XB_TMO      128
#define XB_XCNT(j)  (256  + 64 * (j))
#define XB_XSUB(j)  (1280 + 64 * (j))
#define XB_XGEN(j)  (2304 + 64 * (j))
#define XB_TOP      3328
#define XB_TOPGEN   3392
#define XCD_BAR_WORDS 3456
#define XB_SPIN_CAP (1u << 18)

__device__ __forceinline__ unsigned xb_ld(unsigned* p)              { return __hip_atomic_load(p, __ATOMIC_RELAXED, __HIP_MEMORY_SCOPE_AGENT); }
__device__ __forceinline__ unsigned xb_add(unsigned* p, unsigned v) { return __hip_atomic_fetch_add(p, v, __ATOMIC_RELAXED, __HIP_MEMORY_SCOPE_AGENT); }
__device__ __forceinline__ unsigned xb_xcc_id() { return (unsigned)__builtin_amdgcn_s_getreg((3 << 11) | 20) & 0xFu; }
#define XB_SPIN(cond, bar) do { unsigned _sp = 0; while (cond) { __builtin_amdgcn_s_sleep(1); \
    if ((++_sp & 255u) == 0u) { if (xb_ld(&(bar)[XB_TMO])) break; if (_sp > XB_SPIN_CAP) { atomicAdd(&(bar)[XB_TMO], 1u); break; } } } } while (0)

struct XcdBarrier {
    unsigned* bar; unsigned x;
    volatile LAS unsigned* st;
};

__device__ __forceinline__ XcdBarrier xcd_barrier_post(unsigned* bar, volatile LAS unsigned* st) {
    XcdBarrier b; b.bar = bar; b.x = xb_xcc_id(); b.st = st;
    if (threadIdx.x == 0) (void)xb_add(&bar[XB_XCNT(b.x)], 1u);
    return b;
}
__device__ __forceinline__ void xcd_barrier_complete(unsigned* bar, unsigned x, unsigned& nloc, unsigned& nx) {
    const unsigned G = gridDim.x * gridDim.y * gridDim.z;
    unsigned sum, cnt, mine, sp = 0u;
    for (;;) {
        sum = 0u; cnt = 0u; mine = 0u;
#pragma unroll
        for (unsigned j = 0; j < 16; ++j) { const unsigned c = xb_ld(&bar[XB_XCNT(j)]); sum += c; cnt += (c > 0u) ? 1u : 0u; mine = (j == x) ? c : mine; }
        if (sum == G) break;
        __builtin_amdgcn_s_sleep(1);
        if ((++sp & 255u) == 0u) { if (xb_ld(&bar[XB_TMO])) break; if (sp > XB_SPIN_CAP) { atomicAdd(&bar[XB_TMO], 1u); break; } }
    }
    nloc = mine > 0u ? mine : 1u; nx = cnt > 0u ? cnt : 1u;
}

__device__ __forceinline__ void xcd_barrier(const XcdBarrier& b) {
    asm volatile("s_waitcnt vmcnt(0)" ::: "memory");
    __syncthreads();
    if (threadIdx.x == 0) {
        unsigned* bar = b.bar;
        __builtin_amdgcn_s_waitcnt(0);
        unsigned nloc = b.st[0], nx = b.st[1];
        if (nloc == 0u) { xcd_barrier_complete(bar, b.x, nloc, nx); b.st[0] = nloc; b.st[1] = nx; }
        const unsigned old = xb_add(&bar[XB_XSUB(b.x)], 1u);
        const unsigned gen = old / nloc;
        if (old + 1u == (gen + 1u) * nloc) {
            __builtin_amdgcn_fence(__ATOMIC_RELEASE, "agent");
            asm volatile("s_waitcnt vmcnt(0)" ::: "memory");
            const unsigned og = xb_add(&bar[XB_TOP], 1u);
            const unsigned tg = og / nx;
            if (og + 1u == (tg + 1u) * nx) xb_add(&bar[XB_TOPGEN], 1u);
            else XB_SPIN(xb_ld(&bar[XB_TOPGEN]) == tg, bar);
            __builtin_amdgcn_fence(__ATOMIC_ACQUIRE, "agent");
            xb_add(&bar[XB_XGEN(b.x)], 1u);
            asm volatile("s_waitcnt vmcnt(0)" ::: "memory");
        } else {
            XB_SPIN(xb_ld(&bar[XB_XGEN(b.x)]) == gen, bar);
            __builtin_amdgcn_fence(__ATOMIC_ACQUIRE, "agent");
            asm volatile("s_waitcnt vmcnt(0)" ::: "memory");
        }
    }
    __syncthreads();
}

__device__ __forceinline__ float dpp_ror1(float v) { float r; asm volatile("s_nop 1\n\tv_mov_b32_dpp %0, %1 row_ror:1 row_mask:0xf bank_mask:0xf" : "=v"(r) : "v"(v)); return r; }
__device__ __forceinline__ float dpp_ror2(float v) { float r; asm volatile("s_nop 1\n\tv_mov_b32_dpp %0, %1 row_ror:2 row_mask:0xf bank_mask:0xf" : "=v"(r) : "v"(v)); return r; }
struct EpiX {
    static constexpr bool PERM = true, AFTER_DRAIN = false;
    int mode; bf16_t* Ob; int ldc; const bf16_t* Gs; const float* xin; const bf16_t* xinb; bf16_t* xoutb; const float* gate; const float* cw; const float* cb; bf16_t* Ue;
    __device__ __forceinline__ void ffn_epi(const f32x4 (&acc)[2][2][4][2], const pg8::Unit& u, int wr, int wc, int fr, int fq) const {
        const int j0 = u.pn * 128 + wc * 32 + 8 * fq;
#pragma unroll
        for (int n = 0; n < 2; ++n) {
            const int jn = j0 + 4 * n;
            const f32x4 wg0 = *(const f32x4*)(cw + jn), wg1 = *(const f32x4*)(cw + UP_N + jn), wg2 = *(const f32x4*)(cw + 2 * UP_N + jn), bg = *(const f32x4*)(cb + jn);
            const f32x4 wv0 = *(const f32x4*)(cw + DFF + jn), wv1 = *(const f32x4*)(cw + UP_N + DFF + jn), wv2 = *(const f32x4*)(cw + 2 * UP_N + DFF + jn), bv = *(const f32x4*)(cb + DFF + jn);
#pragma unroll
            for (int ai = 0; ai < 2; ++ai)
#pragma unroll
                for (int m = 0; m < 4; ++m) {
                    const f32x4 xg = acc[ai][0][m][n], xv = acc[ai][1][m][n];
                    const f32x4 pg = (m > 0) ? acc[ai][0][m > 0 ? m - 1 : 0][n] : (f32x4){0.f, 0.f, 0.f, 0.f};
                    const f32x4 pv = (m > 0) ? acc[ai][1][m > 0 ? m - 1 : 0][n] : (f32x4){0.f, 0.f, 0.f, 0.f};
                    float o[4];
#pragma unroll
                    for (int i = 0; i < 4; ++i) {
                        const float ga = dpp_ror1(xg[i]), gb = dpp_ror1(pg[i]), gc = dpp_ror2(xg[i]), gd = dpp_ror2(pg[i]);
                        const float va = dpp_ror1(xv[i]), vb = dpp_ror1(pv[i]), vc = dpp_ror2(xv[i]), vd = dpp_ror2(pv[i]);
                        const float g1 = (fr >= 1) ? ga : gb, g2 = (fr >= 2) ? gc : gd;
                        const float v1 = (fr >= 1) ? va : vb, v2 = (fr >= 2) ? vc : vd;
                        const float cg = bg[i] + wg0[i] * g2 + wg1[i] * g1 + wg2[i] * xg[i];
                        const float cv = bv[i] + wv0[i] * v2 + wv1[i] * v1 + wv2[i] * xv[i];
                        o[i] = siluf_(cg) * cv;
                    }
                    const int row = u.pm * 256 + ai * 128 + wr * 64 + m * 16 + fr;
                    u32x2 pk; pk.x = pk2(o[0], o[1]); pk.y = pk2(o[2], o[3]);
                    *(u32x2*)(Ob + (size_t)row * DFF + jn) = pk;
                    if ((m == 0 && fr < 2) || (m == 3 && fr >= 14)) {
                        const int grp = u.pm * 4 + ai * 2 + wr, k = (m == 0) ? fr : fr - 12;
                        bf16_t* ep = Ue + ((size_t)grp * 4 + k) * UP_N + jn;
                        u32x2 eg, ev; eg.x = pk2(xg[0], xg[1]); eg.y = pk2(xg[2], xg[3]); ev.x = pk2(xv[0], xv[1]); ev.y = pk2(xv[2], xv[3]);
                        *(u32x2*)ep = eg; *(u32x2*)(ep + DFF) = ev;
                    }
                    __builtin_amdgcn_sched_barrier(0);
                }
        }
    }
    __device__ __forceinline__ void operator()(const f32x4 (&acc)[2][2][4][2], const pg8::Unit& u, int wr, int wc, int fr, int fq) const {
        if (mode == 6) { ffn_epi(acc, u, wr, wc, fr, fq); return; }
        const int row0 = u.pm * 256 + wr * 64 + fr, col0 = u.pn * 256 + wc * 32 + 8 * fq;
#pragma unroll
        for (int ai = 0; ai < 2; ++ai)
#pragma unroll
            for (int m = 0; m < 4; ++m) {
                const int row = row0 + ai * 128 + m * 16;
#pragma unroll
                for (int bj = 0; bj < 2; ++bj) {
                    const int col = col0 + bj * 128;
                    f32x4 v0 = acc[ai][bj][m][0], v1 = acc[ai][bj][m][1];
                    if (mode == 0) {
                        u32x4 w; w.x = pk2(v0[0], v0[1]); w.y = pk2(v0[2], v0[3]); w.z = pk2(v1[0], v1[1]); w.w = pk2(v1[2], v1[3]);
                        *(u32x4*)(Ob + (size_t)row * ldc + col) = w;
                    } else if (mode == 1) {
                        u32x4 w; w.x = pk2(sigmoidf_(v0[0]), sigmoidf_(v0[1])); w.y = pk2(sigmoidf_(v0[2]), sigmoidf_(v0[3]));
                        w.z = pk2(sigmoidf_(v1[0]), sigmoidf_(v1[1])); w.w = pk2(sigmoidf_(v1[2]), sigmoidf_(v1[3]));
                        *(u32x4*)(Ob + (size_t)(col >> 10) * ((size_t)M * 1024) + (size_t)row * 1024 + (col & 1023)) = w;
                    } else if (mode <= 4) {
                        const size_t off = (size_t)row * 1024 + col;
                        const u32x4 gw = *(const u32x4*)(Gs + off);
                        float g[8]; unpack8(gw, g);
                        float t[8] = {g[0] * v0[0], g[1] * v0[1], g[2] * v0[2], g[3] * v0[3], g[4] * v1[0], g[5] * v1[1], g[6] * v1[2], g[7] * v1[3]};
                        if (mode >= 3) { float p[8]; unpack8(*(const u32x4*)(Ob + off), p);
#pragma unroll
                            for (int i = 0; i < 8; ++i) t[i] += p[i]; }
                        *(u32x4*)(Ob + off) = pack8(t);
                    } else {
                        const size_t off = (size_t)row * 1024 + col;
                        const float* gp = gate + (size_t)(row >> 11) * 6144 + col;
                        const f32x4 g0 = *(const f32x4*)gp, g1 = *(const f32x4*)(gp + 4);
                        float xr[8];
                        if (xin) { const f32x4 x0 = *(const f32x4*)(xin + off), x1 = *(const f32x4*)(xin + off + 4); xr[0] = x0[0]; xr[1] = x0[1]; xr[2] = x0[2]; xr[3] = x0[3]; xr[4] = x1[0]; xr[5] = x1[1]; xr[6] = x1[2]; xr[7] = x1[3]; }
                        else unpack8(*(const u32x4*)(xinb + off), xr);
                        const f32x4 r0 = g0 * v0, r1 = g1 * v1;
                        xr[0] += r0[0]; xr[1] += r0[1]; xr[2] += r0[2]; xr[3] += r0[3]; xr[4] += r1[0]; xr[5] += r1[1]; xr[6] += r1[2]; xr[7] += r1[3];
                        *(u32x4*)(xoutb + off) = pack8(xr);
                    }
                }
            }
    }
};

__device__ __forceinline__ void tr_item(const float* W, int K, int Nsrc, int col0, int ncols, bf16_t* WT, int nblk, LAS float* scr, int item, int lane) {
    const int kb = item / nblk, nb = item % nblk, k0 = 64 * kb, n0 = 32 * nb;
    const int nq = 4 * (lane & 7), kr = lane >> 3;
#pragma unroll
    for (int i = 0; i < 8; ++i) {
        const int kk = 8 * i + kr;
        f32x4 v = {0.f, 0.f, 0.f, 0.f};
        if (n0 + nq < ncols) v = __builtin_nontemporal_load((const f32x4*)(W + (size_t)(k0 + kk) * Nsrc + col0 + n0 + nq));
        scr[kk * 33 + nq] = v[0]; scr[kk * 33 + nq + 1] = v[1]; scr[kk * 33 + nq + 2] = v[2]; scr[kk * 33 + nq + 3] = v[3];
    }
    asm volatile("s_waitcnt lgkmcnt(0)" ::: "memory");
    const int c = lane & 7;
#pragma unroll
    for (int j = 0; j < 4; ++j) { const int nn = (lane >> 3) + 8 * j; const LAS float* s = scr + (8 * c) * 33 + nn;
        u32x4 o; o.x = pk2(s[0 * 33], s[1 * 33]); o.y = pk2(s[2 * 33], s[3 * 33]); o.z = pk2(s[4 * 33], s[5 * 33]); o.w = pk2(s[6 * 33], s[7 * 33]);
        *(u32x4*)(WT + (size_t)(n0 + nn) * K + k0 + 8 * c) = o; }
    asm volatile("s_waitcnt lgkmcnt(0)" ::: "memory");
}

__device__ __forceinline__ void phase_convert(const Params& P, int l, unsigned char* lds) {
    const int tid = ltid(), lane = tid & 63, wave = __builtin_amdgcn_readfirstlane(tid >> 6);
    LAS float* scr = (LAS float*)lds + wave * (64 * 33);
    const int gw = blockIdx.x * 8 + wave, NGW = gridDim.x * 8;
    unsigned char* ws = P.ws;
    constexpr int I0 = 16 * 56, I1 = 16 * 128, I2 = 16 * 96, I3 = 8 * 32, I4 = 8 * 32, I5 = 16 * 32, I6 = 16 * 32, I7 = 16 * 176, I8 = 44 * 32;
    constexpr int I9 = 16, I10 = 16, I11 = 32, I12 = 16 * 8;
    constexpr int NIT = I0 + I1 + I2 + I3 + I4 + I5 + I6 + I7 + I8 + I9 + I10 + I11 + I12;
    const float* win = P.in[I_WIN] + (size_t)l * 1024 * NIN;
    for (int it = gw; it < NIT; it += NGW) {
        int r = it;
        if (r < I0) { tr_item(win, 1024, NIN, 0, 1792, (bf16_t*)(ws + OFF_WRW), 56, scr, r, lane); continue; } r -= I0;
        if (r < I1) { tr_item(win, 1024, NIN, 1792, SM_N, (bf16_t*)(ws + OFF_WSM), 128, scr, r, lane); continue; } r -= I1;
        if (r < I2) { tr_item(win, 1024, NIN, 5904, 3072, (bf16_t*)(ws + OFF_WG), 96, scr, r, lane); continue; } r -= I2;
        if (r < I3) { tr_item(P.in[I_RWWO] + (size_t)l * 512 * 1024, 512, 1024, 0, 1024, (bf16_t*)(ws + OFF_WRWO), 32, scr, r, lane); continue; } r -= I3;
        if (r < I4) { tr_item(P.in[I_SBWO] + (size_t)l * 512 * 1024, 512, 1024, 0, 1024, (bf16_t*)(ws + OFF_WSBO), 32, scr, r, lane); continue; } r -= I4;
        if (r < I5) { tr_item(P.in[I_M2WO] + (size_t)l * 1024 * 1024, 1024, 1024, 0, 1024, (bf16_t*)(ws + OFF_WM2O), 32, scr, r, lane); continue; } r -= I5;
        if (r < I6) { tr_item(P.in[I_WOUT] + (size_t)l * 1024 * 1024, 1024, 1024, 0, 1024, (bf16_t*)(ws + OFF_WOUT), 32, scr, r, lane); continue; } r -= I6;
        if (r < I7) { const int kb = r / 176, nbk = r % 176, pn = nbk >> 3, q = nbk & 7, srccol = ((q >> 2) ? DFF : 0) + 128 * pn + 32 * (q & 3);
            tr_item(P.in[I_FUP] + (size_t)l * 1024 * UP_N, 1024, UP_N, srccol, 32, (bf16_t*)(ws + OFF_WUP) + (size_t)(32 * nbk) * 1024, 1, scr, kb, lane); continue; } r -= I7;
        if (r < I8) { tr_item(P.in[I_FDOWN] + (size_t)l * DFF * 1024, DFF, 1024, 0, 1024, (bf16_t*)(ws + OFF_WDOWN), 32, scr, r, lane); continue; } r -= I8;
        if (r < I9) { tr_item(P.in[I_W2] + (size_t)l * 64 * 512, 64, 512, 0, 512, (bf16_t*)(ws + OFF_LORA), 16, scr, r, lane); continue; } r -= I9;
        if (r < I10) { tr_item(P.in[I_A2] + (size_t)l * 64 * 512, 64, 512, 0, 512, (bf16_t*)(ws + OFF_LORA + 65536), 16, scr, r, lane); continue; } r -= I10;
        if (r < I11) { tr_item(P.in[I_G2] + (size_t)l * 128 * 512, 128, 512, 0, 512, (bf16_t*)(ws + OFF_LORA + 131072), 16, scr, r, lane); continue; } r -= I11;
        tr_item(win, 1024, NIN, 5888, 16, (bf16_t*)(ws + OFF_WRW) + (size_t)1792 * 1024, 8, scr, r, lane);
    }
}

__device__ __forceinline__ void phase_mod(const Params& P, unsigned char* lds) {
    const int tid = ltid();
    float* sc = (float*)lds;
    float* red = (float*)lds + 8192;
    float* mod = (float*)(P.ws + OFF_MOD);
    bool loaded = false;
    for (int item = blockIdx.x; item < 2 * 96; item += gridDim.x) {
        if (!loaded) { for (int i = tid; i < 8192; i += 512) sc[i] = siluf_(P.in[I_C][i]); loaded = true; }
        __syncthreads();
        const int l = item / 96, cb = item % 96, kg = tid >> 4, c4 = 4 * (tid & 15);
        const float* w = P.in[I_ADAW] + (size_t)l * 1024 * 6144 + cb * 64 + c4;
        f32x4 acc[8];
#pragma unroll
        for (int b = 0; b < 8; ++b) acc[b] = (f32x4){0.f, 0.f, 0.f, 0.f};
#pragma unroll 8
        for (int k = kg * 32; k < kg * 32 + 32; ++k) {
            const f32x4 wv = __builtin_nontemporal_load((const f32x4*)(w + (size_t)k * 6144));
#pragma unroll
            for (int b = 0; b < 8; ++b) acc[b] += wv * sc[b * 1024 + k];
        }
#pragma unroll
        for (int b = 0; b < 8; ++b) *(f32x4*)(red + (kg * 8 + b) * 64 + c4) = acc[b];
        __syncthreads();
        { const int b = tid >> 6, cl = tid & 63, col = cb * 64 + cl; float s = 0.f;
#pragma unroll 8
          for (int g = 0; g < 32; ++g) s += red[(g * 8 + b) * 64 + cl];
          mod[((size_t)l * 8 + b) * 6144 + col] = s + P.in[I_ADAB][(size_t)l * 6144 + col]; }
        __syncthreads();
    }
    __syncthreads();
}

__device__ __forceinline__ void phase_norm_mod(const float* x, const bf16_t* xb, const float* g, const float* shift, const float* scale, bf16_t* XN) {
    const int tid = ltid(), lane = tid & 63, wave = tid >> 6;
    const int gw = blockIdx.x * 8 + wave, NGW = gridDim.x * 8;
    for (int m = gw; m < M; m += NGW) {
        const int b = m >> 11;
        if (x) {
            const f32x4* xr = (const f32x4*)(x + (size_t)m * D) + lane;
            f32x4 v[4]; float s = 0.f;
#pragma unroll
            for (int j = 0; j < 4; ++j) { v[j] = __builtin_nontemporal_load(xr + 64 * j); s += (v[j].x * v[j].x + v[j].y * v[j].y) + (v[j].z * v[j].z + v[j].w * v[j].w); }
            const float rstd = __builtin_amdgcn_rsqf(wave_sum(s) * (1.f / D) + 1e-6f);
            unsigned long long* o8 = (unsigned long long*)(XN + (size_t)m * D) + lane;
#pragma unroll
            for (int j = 0; j < 4; ++j) {
                const int c = 4 * lane + 256 * j;
                const f32x4 gg = *(const f32x4*)(g + c), sh = *(const f32x4*)(shift + (size_t)b * 6144 + c), sl = *(const f32x4*)(scale + (size_t)b * 6144 + c);
                const f32x4 h = (v[j] * rstd * gg) * (1.0f + sl) + sh;
                o8[64 * j] = (unsigned long long)pk2(h.x, h.y) | ((unsigned long long)pk2(h.z, h.w) << 32);
            }
        } else {
            float v[2][8]; float s = 0.f;
#pragma unroll
            for (int j = 0; j < 2; ++j) { unpack8(*(const u32x4*)(xb + (size_t)m * D + 512 * j + 8 * lane), v[j]);
#pragma unroll
                for (int i = 0; i < 8; ++i) s += v[j][i] * v[j][i]; }
            const float rstd = __builtin_amdgcn_rsqf(wave_sum(s) * (1.f / D) + 1e-6f);
#pragma unroll
            for (int j = 0; j < 2; ++j) {
                const int c = 512 * j + 8 * lane; float h[8];
#pragma unroll
                for (int q = 0; q < 2; ++q) { const f32x4 gg = *(const f32x4*)(g + c + 4 * q), sh = *(const f32x4*)(shift + (size_t)b * 6144 + c + 4 * q), sl = *(const f32x4*)(scale + (size_t)b * 6144 + c + 4 * q);
#pragma unroll
                    for (int i = 0; i < 4; ++i) h[4 * q + i] = (v[j][4 * q + i] * rstd * gg[i]) * (1.0f + sl[i]) + sh[i]; }
                *(u32x4*)(XN + (size_t)m * D + c) = pack8(h);
            }
        }
    }
}
__device__ __forceinline__ void phase_final_norm(const bf16_t* xb, float* out, const float* g, const XcdBarrier& xbar_) {
    const int tid = ltid(), lane = tid & 63, wave = tid >> 6;
    const int gw = blockIdx.x * 8 + wave, NGW = gridDim.x * 8;
    u32x4 raw[8][2];
#pragma unroll
    for (int k = 0; k < 8; ++k) { const int m = gw + k * NGW;
#pragma unroll
        for (int j = 0; j < 2; ++j) { raw[k][j] = (u32x4){0u, 0u, 0u, 0u}; if (m < M) raw[k][j] = *(const u32x4*)(xb + (size_t)m * D + 512 * j + 8 * lane); } }
    asm volatile("s_waitcnt vmcnt(0)" ::: "memory");
    xcd_barrier(xbar_);
#pragma unroll
    for (int k = 0; k < 8; ++k) { const int m = gw + k * NGW;
        float v[2][8]; float s = 0.f;
#pragma unroll
        for (int j = 0; j < 2; ++j) { unpack8(raw[k][j], v[j]);
#pragma unroll
            for (int i = 0; i < 8; ++i) s += v[j][i] * v[j][i]; }
        const float rstd = __builtin_amdgcn_rsqf(wave_sum(s) * (1.f / D) + 1e-6f);
        if (m < M) {
#pragma unroll
            for (int j = 0; j < 2; ++j)
#pragma unroll
                for (int q = 0; q < 2; ++q) { const int c = 512 * j + 8 * lane + 4 * q; const f32x4 gg = *(const f32x4*)(g + c);
                    *(f32x4*)(out + (size_t)m * D + c) = (f32x4){v[j][4 * q] * rstd * gg[0], v[j][4 * q + 1] * rstd * gg[1], v[j][4 * q + 2] * rstd * gg[2], v[j][4 * q + 3] * rstd * gg[3]}; }
        }
    }
}

__device__ __forceinline__ void lerp4(const bf16_t* pc, bool hasprev, const float* mu, float* out) {
    const u32x2 cw = *(const u32x2*)pc; u32x2 pw = *(const u32x2*)(hasprev ? pc - PRW_LD : pc);
    pw.x = hasprev ? pw.x : 0u; pw.y = hasprev ? pw.y : 0u;
    const f32x4 m4 = *(const f32x4*)mu;
    const float c0 = bf2f(cw.x & 0xffffu), c1 = bf2f(cw.x >> 16), c2 = bf2f(cw.y & 0xffffu), c3 = bf2f(cw.y >> 16);
    const float p0 = bf2f(pw.x & 0xffffu), p1 = bf2f(pw.x >> 16), p2 = bf2f(pw.y & 0xffffu), p3 = bf2f(pw.y >> 16);
    out[0] = c0 + (p0 - c0) * m4[0]; out[1] = c1 + (p1 - c1) * m4[1]; out[2] = c2 + (p2 - c2) * m4[2]; out[3] = c3 + (p3 - c3) * m4[3];
}
__device__ __forceinline__ void lerp8(const bf16_t* pc, bool hasprev, const float* mu, float* out) {
    const u32x4 cw = *(const u32x4*)pc; u32x4 pw = *(const u32x4*)(hasprev ? pc - PRW_LD : pc);
    pw.x = hasprev ? pw.x : 0u; pw.y = hasprev ? pw.y : 0u; pw.z = hasprev ? pw.z : 0u; pw.w = hasprev ? pw.w : 0u;
    float c[8], p[8]; unpack8(cw, c); unpack8(pw, p);
#pragma unroll
    for (int i = 0; i < 8; ++i) out[i] = c[i] + (p[i] - c[i]) * mu[i];
}
__device__ __forceinline__ u32x2 pack4(const float* f) { u32x2 w; w.x = pk2(f[0], f[1]); w.y = pk2(f[2], f[3]); return w; }
constexpr int PL_S64 = 72, PL_S128 = 136;
__device__ __forceinline__ void phase_rwkv_pre(const Params& P, int l, unsigned char* lds) {
    const int tid = ltid(), lane = tid & 63, hw = __builtin_amdgcn_readfirstlane(tid >> 6);
    const int r32 = lane & 31, hi = lane >> 5;
    bf16_t* Lw = (bf16_t*)lds; bf16_t* La = Lw + 64 * PL_S64; bf16_t* Lg = La + 64 * PL_S64;
    unsigned char* ws = P.ws;
    const bf16_t* Prw = (const bf16_t*)(ws + OFF_PRW);
    bf16_t* Sr = (bf16_t*)(ws + OFF_SR); bf16_t* Sk = (bf16_t*)(ws + OFF_SK); bf16_t* Sv = (bf16_t*)(ws + OFF_SV);
    bf16_t* Skk = (bf16_t*)(ws + OFF_SKK); bf16_t* Skka = (bf16_t*)(ws + OFF_SKKA); float* Sw = (float*)(ws + OFF_SW); bf16_t* Sg = (bf16_t*)(ws + OFF_SG);
    const bf16_t* w2t = (const bf16_t*)(ws + OFF_LORA); const bf16_t* a2t = w2t + 512 * 64; const bf16_t* g2t = a2t + 512 * 64;
    const float* mu = P.in[I_MU] + (size_t)l * RW_IN;
    const float* w0 = P.in[I_W0] + l * 512; const float* a0 = P.in[I_A0] + l * 512;
    const float* k_k = P.in[I_KK] + l * 512; const float* k_a = P.in[I_KA] + l * 512;
    for (int tile = blockIdx.x; tile < M / 64; tile += gridDim.x) {
        {
            const int m = tile * 64 + lane; const bool hasprev = (m & (SEQ - 1)) != 0;
            const bf16_t* prow = Prw + (size_t)m * PRW_LD;
            const int jb = hw * 32;
#pragma unroll
            for (int q = 0; q < 4; ++q) {
                float x[8]; lerp8(prow + 1536 + jb + 8 * q, hasprev, mu + 1536 + jb + 8 * q, x);
#pragma unroll
                for (int i = 0; i < 8; ++i) {
                    float v = x[i];
                    if (hw < 2) { const float e2 = __expf(2.f * v); v = 1.f - 2.f * __builtin_amdgcn_rcpf(e2 + 1.f); }
                    else if (hw >= 4) v = sigmoidf_(v);
                    x[i] = v;
                }
                const u32x4 pk = pack8(x);
                if (hw < 2) *(u32x4*)(Lw + lane * PL_S64 + jb + 8 * q) = pk;
                else if (hw < 4) *(u32x4*)(La + lane * PL_S64 + (jb - 64) + 8 * q) = pk;
                else *(u32x4*)(Lg + lane * PL_S128 + (jb - 128) + 8 * q) = pk;
            }
        }
        if (hw == 7) { const int m_ = tile * 64 + lane; const u32x4 d0 = *(const u32x4*)(Prw + (size_t)m_ * PRW_LD + 1792), d1 = *(const u32x4*)(Prw + (size_t)m_ * PRW_LD + 1800);
            bf16_t* dp = (bf16_t*)(ws + OFF_DT) + (size_t)m_ * 16; *(u32x4*)dp = d0; *(u32x4*)(dp + 8) = d1; }
        __syncthreads();
        for (int ct = 0; ct < 2; ++ct) {
            const int m = tile * 64 + 32 * ct + r32; const bool hasprev = (m & (SEQ - 1)) != 0;
            const bf16_t* prow = Prw + (size_t)m * PRW_LD;
            float ss = 0.f;
#pragma unroll
            for (int rt = 0; rt < 2; ++rt)
#pragma unroll
                for (int g = 0; g < 4; ++g) { const int c4 = 64 * hw + 32 * rt + 8 * g + 4 * hi; float k0[4]; lerp4(prow + 512 + c4, hasprev, mu + 512 + c4, k0);
                    const f32x4 kk4 = *(const f32x4*)(k_k + c4);
                    const float t0 = k0[0] * kk4[0], t1 = k0[1] * kk4[1], t2 = k0[2] * kk4[2], t3 = k0[3] * kk4[3]; ss += (t0 * t0 + t1 * t1) + (t2 * t2 + t3 * t3); }
            ss += __shfl_xor(ss, 32);
            const float inv = __builtin_amdgcn_rsqf(fmaxf(ss, 1e-24f));
            for (int rt = 0; rt < 2; ++rt) {
                const int cbase = 64 * hw + 32 * rt;
                f32x16 accw = {}, acca = {}, accg = {};
#pragma unroll
                for (int k0 = 0; k0 < 64; k0 += 16) {
                    const bf16x8 aw = *(const bf16x8*)(w2t + (size_t)(cbase + r32) * 64 + k0 + 8 * hi);
                    const bf16x8 aa = *(const bf16x8*)(a2t + (size_t)(cbase + r32) * 64 + k0 + 8 * hi);
                    const bf16x8 bw = *(const bf16x8*)(Lw + (32 * ct + r32) * PL_S64 + k0 + 8 * hi);
                    const bf16x8 ba = *(const bf16x8*)(La + (32 * ct + r32) * PL_S64 + k0 + 8 * hi);
                    accw = __builtin_amdgcn_mfma_f32_32x32x16_bf16(aw, bw, accw, 0, 0, 0);
                    acca = __builtin_amdgcn_mfma_f32_32x32x16_bf16(aa, ba, acca, 0, 0, 0);
                }
#pragma unroll
                for (int k0 = 0; k0 < 128; k0 += 16) {
                    const bf16x8 ag = *(const bf16x8*)(g2t + (size_t)(cbase + r32) * 128 + k0 + 8 * hi);
                    const bf16x8 bg = *(const bf16x8*)(Lg + (32 * ct + r32) * PL_S128 + k0 + 8 * hi);
                    accg = __builtin_amdgcn_mfma_f32_32x32x16_bf16(ag, bg, accg, 0, 0, 0);
                }
                bf16_t* stg = (bf16_t*)(lds + 35840) + hw * (6 * 1024);
                float wdall[16];
#pragma unroll
                for (int g = 0; g < 4; ++g) {
                    const int c4 = cbase + 8 * g + 4 * hi;
                    float r4[4], k4[4], v4[4];
                    lerp4(prow + c4, hasprev, mu + c4, r4); lerp4(prow + 512 + c4, hasprev, mu + 512 + c4, k4); lerp4(prow + 1024 + c4, hasprev, mu + 1024 + c4, v4);
                    const f32x4 w04 = *(const f32x4*)(w0 + c4), a04 = *(const f32x4*)(a0 + c4), kk4 = *(const f32x4*)(k_k + c4), ka4 = *(const f32x4*)(k_a + c4);
                    float kkv[4], kka[4], kn[4], gg[4];
#pragma unroll
                    for (int i = 0; i < 4; ++i) {
                        const float lw = w04[i] + accw[4 * g + i];
                        const float logw = -softplusf_(-lw) - 0.5f;
                        wdall[4 * g + i] = __expf(-__expf(logw));
                        const float a = sigmoidf_(a04[i] + acca[4 * g + i]);
                        gg[i] = accg[4 * g + i];
                        const float kv_ = k4[i] * kk4[i] * inv;
                        kkv[i] = kv_; kka[i] = kv_ * a;
                        kn[i] = k4[i] * (1.0f + (a - 1.0f) * ka4[i]);
                    }
                    bf16_t* sp = stg + r32 * 32 + 8 * g + 4 * hi;
                    *(u32x2*)(sp) = pack4(r4); *(u32x2*)(sp + 1024) = pack4(kn); *(u32x2*)(sp + 2048) = pack4(v4);
                    *(u32x2*)(sp + 3072) = pack4(kkv); *(u32x2*)(sp + 4096) = pack4(kka); *(u32x2*)(sp + 5120) = pack4(gg);
                }
                asm volatile("" ::: "memory");
                {
                    const size_t mb = (size_t)(tile * 64 + 32 * ct);
                    const int rrow = lane >> 2, rch = 8 * (lane & 3);
#pragma unroll
                    for (int hf = 0; hf < 2; ++hf) {
                        const int row = 16 * hf + rrow; const size_t off = (mb + row) * 512 + cbase + rch; const bf16_t* sp = stg + row * 32 + rch;
                        const u32x4 t0 = *(const u32x4*)(sp), t1 = *(const u32x4*)(sp + 1024), t2 = *(const u32x4*)(sp + 2048), t3 = *(const u32x4*)(sp + 3072), t4 = *(const u32x4*)(sp + 4096), t5 = *(const u32x4*)(sp + 5120);
                        *(u32x4*)(Sr + off) = t0; *(u32x4*)(Sk + off) = t1; *(u32x4*)(Sv + off) = t2; *(u32x4*)(Skk + off) = t3; *(u32x4*)(Skka + off) = t4; *(u32x4*)(Sg + off) = t5;
                    }
                    asm volatile("" ::: "memory");
                    float* stf = (float*)stg;
#pragma unroll
                    for (int g = 0; g < 4; ++g) *(f32x4*)(stf + r32 * 32 + 8 * g + 4 * hi) = (f32x4){wdall[4 * g], wdall[4 * g + 1], wdall[4 * g + 2], wdall[4 * g + 3]};
                    asm volatile("" ::: "memory");
                    const int frow = lane >> 3, fch = 4 * (lane & 7);
#pragma unroll
                    for (int q = 0; q < 4; ++q) { const int row = 8 * q + frow; *(f32x4*)(Sw + (mb + row) * 512 + cbase + fch) = *(const f32x4*)(stf + row * 32 + fch); }
                    asm volatile("" ::: "memory");
                }
            }
        }
        __syncthreads();
    }
}

#define LBAR() asm volatile("s_waitcnt lgkmcnt(0)\n\ts_barrier" ::: "memory")
constexpr int SC_TC = 32, SC_STEP = 336;
__device__ __forceinline__ float dpp_xor1(float v) { return __int_as_float(__builtin_amdgcn_update_dpp(0, __float_as_int(v), 0xB1, 0xF, 0xF, false)); }
__device__ __forceinline__ float dpp_xor2(float v) { return __int_as_float(__builtin_amdgcn_update_dpp(0, __float_as_int(v), 0x4E, 0xF, 0xF, false)); }
__device__ __forceinline__ float dpp_hmir(float v) { return __int_as_float(__builtin_amdgcn_update_dpp(0, __float_as_int(v), 0x141, 0xF, 0xF, false)); }
__device__ __forceinline__ float dpp_mir(float v) { return __int_as_float(__builtin_amdgcn_update_dpp(0, __float_as_int(v), 0x140, 0xF, 0xF, false)); }
__device__ __forceinline__ float red16(float s) { s += dpp_xor1(s); s += dpp_xor2(s); s += dpp_hmir(s); s += dpp_mir(s); return s; }
constexpr int SC_T2 = 16;
__device__ __forceinline__ void phase_scan(const Params& P, unsigned char* lds) {
    const int tid = ltid(), lane = tid & 63, wave = __builtin_amdgcn_readfirstlane(tid >> 6);
    unsigned char* ws = P.ws;
    const bf16_t* Sr = (const bf16_t*)(ws + OFF_SR); const bf16_t* Sk = (const bf16_t*)(ws + OFF_SK); const bf16_t* Sv = (const bf16_t*)(ws + OFF_SV);
    const bf16_t* Skk = (const bf16_t*)(ws + OFF_SKK); const bf16_t* Skka = (const bf16_t*)(ws + OFF_SKKA); const float* Sw = (const float*)(ws + OFF_SW);
    bf16_t* Yraw = (bf16_t*)(ws + OFF_YRAW);
    float* buf = (float*)lds;
    float* ypart = (float*)lds + 2 * SC_T2 * SC_STEP;
    for (int job = blockIdx.x; job < 256; job += gridDim.x) {
        const int chain = job >> 2, rg = job & 3, b = chain >> 3, h = chain & 7;
        const size_t rowbase = (size_t)b * SEQ; const int cb = 64 * h, vb = cb + 16 * rg;
        constexpr int NCH = SEQ / SC_T2;
        f32x2 S0 = {0.f, 0.f}, S1 = {0.f, 0.f};
        const int r = lane >> 4, jg = lane & 15;
        const int lt = tid - 256;
        u32x4 ldA[4], ldB[4];
#define SC_ISSUE(LD, cc) do { if ((cc) < NCH) { const size_t m0_ = rowbase + (size_t)(cc) * SC_T2; \
            _Pragma("unroll") for (int k = 0; k < 4; ++k) { const int it = lt + 256 * k; LD[k] = (u32x4){0u, 0u, 0u, 0u}; \
                if (k == 0) { const int t = it >> 4, part = it & 15; LD[k] = *(const u32x4*)(Sw + (m0_ + t) * 512 + cb + 4 * part); } \
                else if (k < 3) { const int a = (it - 256) >> 7, rem = (it - 256) & 127, t = rem >> 3, part = rem & 7; \
                    const bf16_t* src_ = (a == 0) ? Skka : (a == 1) ? Sk : (a == 2) ? Skk : Sr; LD[k] = *(const u32x4*)(src_ + (m0_ + t) * 512 + cb + 8 * part); } \
                else if (it < 800) { const int rem = it - 768, t = rem >> 1, part = rem & 1; LD[k] = *(const u32x4*)(Sv + (m0_ + t) * 512 + vb + 8 * part); } } } } while (0)
#define SC_COMMIT(LD, cc) do { if ((cc) < NCH) { float* dst_ = buf + ((cc) & 1) * (SC_T2 * SC_STEP); \
            _Pragma("unroll") for (int k = 0; k < 4; ++k) { const int it = lt + 256 * k; \
                if (k == 0) { const int t = it >> 4, part = it & 15; *(u32x4*)(dst_ + t * SC_STEP + 4 * part) = LD[k]; } \
                else if (k < 3) { const int a = (it - 256) >> 7, rem = (it - 256) & 127, t = rem >> 3, part = rem & 7; \
                    float f[8]; unpack8(LD[k], f); float* d = dst_ + t * SC_STEP + 64 * (a + 1) + 8 * part; \
                    *(f32x4*)d = (f32x4){f[0], f[1], f[2], f[3]}; *(f32x4*)(d + 4) = (f32x4){f[4], f[5], f[6], f[7]}; } \
                else if (it < 800) { const int rem = it - 768, t = rem >> 1, part = rem & 1; \
                    float f[8]; unpack8(LD[k], f); float* d = dst_ + t * SC_STEP + 320 + 8 * part; \
                    *(f32x4*)d = (f32x4){f[0], f[1], f[2], f[3]}; *(f32x4*)(d + 4) = (f32x4){f[4], f[5], f[6], f[7]}; } } } } while (0)
#define SC_YRED(cc) do { if ((cc) >= 0) { const float* yp = ypart + ((cc) & 1) * (SC_T2 * 256) + lt * 16; \
            const f32x4 p0 = *(const f32x4*)yp, p1 = *(const f32x4*)(yp + 4), p2 = *(const f32x4*)(yp + 8), p3 = *(const f32x4*)(yp + 12); \
            const f32x4 q = (p0 + p1) + (p2 + p3); \
            Yraw[((size_t)job * SEQ + (size_t)(cc) * SC_T2) * 16 + lt] = (bf16_t)f2bf((q[0] + q[1]) + (q[2] + q[3])); } } while (0)
#define SC_SCAN(cc) do { \
            const float* src = buf + ((cc) & 1) * (SC_T2 * SC_STEP); \
            const int vrow = 4 * wave + r; \
            const float* base0 = src + jg * 4; const float* vbase = src + 320 + vrow; \
            float* ypw = ypart + ((cc) & 1) * (SC_T2 * 256) + vrow * 16 + jg; \
            for (int t = 0; t < SC_T2; t += 4) { \
                SC_LOAD(A, t) SC_LOAD(B, t + 1) \
                __builtin_amdgcn_sched_barrier(0); \
                SC_STEPF(A, t); \
                __builtin_amdgcn_sched_barrier(0); \
                SC_LOAD(C, t + 2) \
                __builtin_amdgcn_sched_barrier(0); \
                SC_STEPF(B, t + 1); \
                __builtin_amdgcn_sched_barrier(0); \
                SC_LOAD(D, t + 3) \
                __builtin_amdgcn_sched_barrier(0); \
                SC_STEPF(C, t + 2); \
                __builtin_amdgcn_sched_barrier(0); \
                SC_STEPF(D, t + 3); \
            } } while (0)
#define SC_LOAD(X, t_) const f32x4 w4##X = *(const f32x4*)(base0 + (t_) * SC_STEP), a4##X = *(const f32x4*)(base0 + (t_) * SC_STEP + 64), k4##X = *(const f32x4*)(base0 + (t_) * SC_STEP + 128), \
                    n4##X = *(const f32x4*)(base0 + (t_) * SC_STEP + 192), r4##X = *(const f32x4*)(base0 + (t_) * SC_STEP + 256); const float vi##X = vbase[(t_) * SC_STEP];
#define SC_STEPF(X, t_) do { \
                    const f32x2 acc = S0 * (f32x2){n4##X[0], n4##X[1]} + S1 * (f32x2){n4##X[2], n4##X[3]}; \
                    const float sa = -red16(acc.x + acc.y); \
                    S0 = S0 * (f32x2){w4##X[0], w4##X[1]} + ((f32x2){a4##X[0], a4##X[1]} * sa + (f32x2){k4##X[0], k4##X[1]} * vi##X); \
                    S1 = S1 * (f32x2){w4##X[2], w4##X[3]} + ((f32x2){a4##X[2], a4##X[3]} * sa + (f32x2){k4##X[2], k4##X[3]} * vi##X); \
                    const f32x2 ya = S0 * (f32x2){r4##X[0], r4##X[1]} + S1 * (f32x2){r4##X[2], r4##X[3]}; \
                    ypw[(t_) * 256] = ya.x + ya.y; } while (0)
        __syncthreads();
        if (wave >= 4) { SC_ISSUE(ldA, 0); SC_ISSUE(ldB, 1); SC_COMMIT(ldA, 0); SC_ISSUE(ldA, 2); }
        LBAR();
        for (int c = 0; c < NCH; c += 2) {
            if (wave >= 4) { SC_COMMIT(ldB, c + 1); SC_ISSUE(ldB, c + 3); SC_YRED(c - 1); }
            else SC_SCAN(c);
            LBAR();
            if (wave >= 4) { SC_COMMIT(ldA, c + 2); SC_ISSUE(ldA, c + 4); SC_YRED(c); }
            else SC_SCAN(c + 1);
            LBAR();
        }
        if (wave >= 4) SC_YRED(NCH - 1);
#undef SC_ISSUE
#undef SC_COMMIT
#undef SC_YRED
#undef SC_SCAN
#undef SC_LOAD
#undef SC_STEPF
    }
    __syncthreads();
}

__device__ __forceinline__ float red8(float s) { s += dpp_xor1(s); s += dpp_xor2(s); s += dpp_hmir(s); return s; }
__device__ __forceinline__ void phase_rwkv_post(const Params& P, int l) {
    const int tid = ltid(), lane = tid & 63, wave = tid >> 6;
    const int gw = blockIdx.x * 8 + wave, NGW = gridDim.x * 8;
    unsigned char* ws = P.ws;
    const bf16_t* Sr = (const bf16_t*)(ws + OFF_SR); const bf16_t* Sk = (const bf16_t*)(ws + OFF_SK); const bf16_t* Sv = (const bf16_t*)(ws + OFF_SV);
    const bf16_t* Sg = (const bf16_t*)(ws + OFF_SG); const bf16_t* Yraw = (const bf16_t*)(ws + OFF_YRAW);
    bf16_t* Yrw = (bf16_t*)(ws + OFF_YRW);
    const float* lng = P.in[I_LNG] + l * 512 + 8 * lane; const float* lnb = P.in[I_LNB] + l * 512 + 8 * lane; const float* rk = P.in[I_RK] + l * 512 + 8 * lane;
    float g8[8], b8[8], k8[8];
    { const f32x4 a = *(const f32x4*)lng, b = *(const f32x4*)(lng + 4); g8[0]=a[0];g8[1]=a[1];g8[2]=a[2];g8[3]=a[3];g8[4]=b[0];g8[5]=b[1];g8[6]=b[2];g8[7]=b[3]; }
    { const f32x4 a = *(const f32x4*)lnb, b = *(const f32x4*)(lnb + 4); b8[0]=a[0];b8[1]=a[1];b8[2]=a[2];b8[3]=a[3];b8[4]=b[0];b8[5]=b[1];b8[6]=b[2];b8[7]=b[3]; }
    { const f32x4 a = *(const f32x4*)rk, b = *(const f32x4*)(rk + 4); k8[0]=a[0];k8[1]=a[1];k8[2]=a[2];k8[3]=a[3];k8[4]=b[0];k8[5]=b[1];k8[6]=b[2];k8[7]=b[3]; }
    for (int m = gw; m < M; m += NGW) {
        const size_t off = (size_t)m * 512 + 8 * lane;
        float y[8], r[8], k[8], v[8], g[8];
        { const int c0 = 8 * lane, hh = c0 >> 6, ii = c0 & 63; const int jobi = ((m >> 11) * 8 + hh) * 4 + (ii >> 4);
          unpack8(*(const u32x4*)(Yraw + ((size_t)jobi * SEQ + (m & (SEQ - 1))) * 16 + (ii & 15)), y); }
        unpack8(*(const u32x4*)(Sr + off), r); unpack8(*(const u32x4*)(Sk + off), k);
        unpack8(*(const u32x4*)(Sv + off), v); unpack8(*(const u32x4*)(Sg + off), g);
        float s = 0.f, rkv = 0.f;
#pragma unroll
        for (int i = 0; i < 8; ++i) { s += y[i]; rkv += r[i] * k[i] * k8[i]; }
        const float mean = red8(s) * (1.f / 64.f); rkv = red8(rkv);
        float q = 0.f;
#pragma unroll
        for (int i = 0; i < 8; ++i) { y[i] -= mean; q += y[i] * y[i]; }
        const float rstd = __builtin_amdgcn_rsqf(red8(q) * (1.f / 64.f) + 64e-5f);
        float o[8];
#pragma unroll
        for (int i = 0; i < 8; ++i) o[i] = (y[i] * rstd * g8[i] + b8[i] + rkv * v[i]) * g[i];
        *(u32x4*)(Yrw + off) = pack8(o);
    }
}

__device__ __forceinline__ int crow(int r, int hi) { return (r & 3) + 8 * (r >> 2) + 4 * hi; }
template <bool DIAG>
__device__ __forceinline__ void attn_tile(f32x16& o0, f32x16& o1, float& C, const bf16x8 (&kf)[4], const bf16x8 (&vf)[4], const bf16x8 (&qr)[4], int kv0, int qabs, int hi) {
    f32x16 p0 = {};
#pragma unroll
    for (int d0 = 0; d0 < 4; ++d0) p0 = __builtin_amdgcn_mfma_f32_32x32x16_bf16(kf[d0], qr[d0], p0, 0, 0, 0);
    f32x16 x0;
#pragma unroll
    for (int r = 0; r < 16; ++r) {
        const float zc = fmaxf(p0[r] * 0.125f, -80.0f); const float e = __expf(-zc); float bt = __builtin_amdgcn_rcpf(1.0f + e); float om = e * bt;
        if (DIAG) { const bool cz = (kv0 + crow(r, hi)) < qabs; bt = cz ? bt : 0.f; om = cz ? om : 1.0f; }
        p0[r] = bt; x0[r] = om;
    }
    float T[4], TO[4];
#pragma unroll
    for (int g = 0; g < 4; ++g) T[g] = (x0[4 * g] * x0[4 * g + 1]) * (x0[4 * g + 2] * x0[4 * g + 3]);
#pragma unroll
    for (int g = 0; g < 4; ++g) TO[g] = __shfl_xor(T[g], 32);
    float offs[4]; float run = 1.0f;
#pragma unroll
    for (int g = 3; g >= 0; --g) { offs[g] = (hi == 0) ? run * TO[g] : run; run *= T[g] * TO[g]; }
#pragma unroll
    for (int g = 0; g < 4; ++g) {
        const float b0 = C * offs[g];
        const float s2 = x0[4 * g + 3], s1 = s2 * x0[4 * g + 2], s0 = s1 * x0[4 * g + 1];
        p0[4 * g + 0] *= b0 * s0; p0[4 * g + 1] *= b0 * s1; p0[4 * g + 2] *= b0 * s2; p0[4 * g + 3] *= b0;
    }
    C *= run;
#pragma unroll
    for (int ks = 0; ks < 2; ++ks) {
        u32x4 pw; pw.x = pk2(p0[8 * ks + 0], p0[8 * ks + 1]); pw.y = pk2(p0[8 * ks + 2], p0[8 * ks + 3]); pw.z = pk2(p0[8 * ks + 4], p0[8 * ks + 5]); pw.w = pk2(p0[8 * ks + 6], p0[8 * ks + 7]);
        const bf16x8 pa = __builtin_bit_cast(bf16x8, pw);
        o0 = __builtin_amdgcn_mfma_f32_32x32x16_bf16(pa, vf[2 * ks], o0, 0, 0, 0);
        o1 = __builtin_amdgcn_mfma_f32_32x32x16_bf16(pa, vf[2 * ks + 1], o1, 0, 0, 0);
    }
}
__device__ __forceinline__ void attn_job(const bf16_t* Psm, bf16_t* Ysb, int b, int h, int qt, int lane, bf16_t* ost) {
    const int r32 = lane & 31, hi = lane >> 5;
    const size_t rowbase = (size_t)b * SEQ; const int q0 = 32 * qt;
    const bf16_t* Qp = Psm + (rowbase + q0 + r32) * SM_NP + 64 * h + 8 * hi;
    const bf16_t* Kb = Psm + rowbase * SM_NP + 512 + 64 * h + 8 * hi;
    const bf16_t* Vb = Psm + rowbase * SM_NP + 1024 + 64 * h + r32;
    bf16x8 qr[4];
#pragma unroll
    for (int d0 = 0; d0 < 4; ++d0) qr[d0] = *(const bf16x8*)(Qp + 16 * d0);
    f32x16 o0 = {}, o1 = {};
    float C = 1.0f;
    const int qabs = q0 + r32;
    bf16x8 kf[4], vf[4], kfn[4], vfn[4];
#define ATT_LOAD(KF, VF, kv0_) do { \
        _Pragma("unroll") for (int d0 = 0; d0 < 4; ++d0) KF[d0] = *(const bf16x8*)(Kb + (size_t)((kv0_) + r32) * SM_NP + 16 * d0); \
        _Pragma("unroll") for (int ks = 0; ks < 2; ++ks) _Pragma("unroll") for (int i = 0; i < 8; ++i) { \
            const int key = (kv0_) + 16 * ks + (i & 3) + 8 * (i >> 2) + 4 * hi; const bf16_t* vp = Vb + (size_t)key * SM_NP; VF[2 * ks][i] = (short)vp[0]; VF[2 * ks + 1][i] = (short)vp[32]; } } while (0)
    ATT_LOAD(kf, vf, q0);
    if (q0 >= 32) ATT_LOAD(kfn, vfn, q0 - 32);
    attn_tile<true>(o0, o1, C, kf, vf, qr, q0, qabs, hi);
    for (int kv0 = q0 - 32; kv0 >= 0; kv0 -= 32) {
        if (__all(C < 1.0e-38f)) break;
#pragma unroll
        for (int d0 = 0; d0 < 4; ++d0) { kf[d0] = kfn[d0]; vf[d0] = vfn[d0]; }
        if (kv0 >= 32) ATT_LOAD(kfn, vfn, kv0 - 32);
        attn_tile<false>(o0, o1, C, kf, vf, qr, kv0, qabs, hi);
    }
#undef ATT_LOAD
#pragma unroll
    for (int r = 0; r < 16; ++r) { bf16_t* rp = ost + crow(r, hi) * 64 + r32; rp[0] = (bf16_t)f2bf(o0[r]); rp[32] = (bf16_t)f2bf(o1[r]); }
    asm volatile("" ::: "memory");
#pragma unroll
    for (int q = 0; q < 4; ++q) { const int row = 8 * q + (lane >> 3);
        *(u32x4*)(Ysb + (rowbase + q0 + row) * 512 + 64 * h + 8 * (lane & 7)) = *(const u32x4*)(ost + row * 64 + 8 * (lane & 7)); }
    asm volatile("" ::: "memory");
}
__device__ __forceinline__ void phase_attn(const Params& P, unsigned char* lds) {
    const int tid = ltid(), lane = tid & 63, wave = tid >> 6;
    const int gw = (blockIdx.x >> 1) * 8 + wave, NGW = (gridDim.x >> 1) * 8;
    const bf16_t* Psm = (const bf16_t*)(P.ws + OFF_PSM); bf16_t* Ysb = (bf16_t*)(P.ws + OFF_YSB);
    for (int job = gw; job < 64 * 64; job += NGW) {
        const int chain = job & 63, qt = 63 - (job >> 6);
        attn_job(Psm, Ysb, chain >> 3, chain & 7, qt, lane, (bf16_t*)lds + wave * 2048);
    }
}

__device__ __forceinline__ void phase_xbc_conv(const Params& P, int l, const XcdBarrier& xb) {
    const int tid = ltid();
    const int gtid = blockIdx.x * 512 + tid;
    bf16_t* Psm = (bf16_t*)(P.ws + OFF_PSM);
    const int cgp = gtid % 192, sgm = gtid / 192;
    const int m0 = 26 * sgm;
    const bool active = (gtid < 192 * 631) && (m0 < M);
    const int ch = 8 * cgp;
    bf16_t* colp = Psm + 2560 + ch;
    u32x4 h0 = {0u, 0u, 0u, 0u}, h1 = h0, h2 = h0;
    if (active) {
        const int t = m0 & (SEQ - 1);
        if (t >= 3) h0 = *(const u32x4*)(colp + (size_t)(m0 - 3) * SM_NP);
        if (t >= 2) h1 = *(const u32x4*)(colp + (size_t)(m0 - 2) * SM_NP);
        if (t >= 1) h2 = *(const u32x4*)(colp + (size_t)(m0 - 1) * SM_NP);
    }
    asm volatile("s_waitcnt vmcnt(0)" ::: "memory");
    xcd_barrier(xb);
    if (active) {
        const float* cw = P.in[I_CONVW] + (size_t)l * 4 * 1536 + ch; const float* cbp = P.in[I_CONVB] + (size_t)l * 1536 + ch;
        float w[4][8], bb[8];
#pragma unroll
        for (int d = 0; d < 4; ++d) { const f32x4 a = *(const f32x4*)(cw + d * 1536), b = *(const f32x4*)(cw + d * 1536 + 4);
            w[d][0] = a[0]; w[d][1] = a[1]; w[d][2] = a[2]; w[d][3] = a[3]; w[d][4] = b[0]; w[d][5] = b[1]; w[d][6] = b[2]; w[d][7] = b[3]; }
        { const f32x4 a = *(const f32x4*)cbp, b = *(const f32x4*)(cbp + 4); bb[0] = a[0]; bb[1] = a[1]; bb[2] = a[2]; bb[3] = a[3]; bb[4] = b[0]; bb[5] = b[1]; bb[6] = b[2]; bb[7] = b[3]; }
        float x0[8], x1[8], x2[8], x3[8];
        unpack8(h0, x0); unpack8(h1, x1); unpack8(h2, x2);
        for (int half = 0; half < 2; ++half) {
            const int mb = m0 + 13 * half;
            u32x4 raw[13];
#pragma unroll
            for (int i = 0; i < 13; ++i) { raw[i] = (u32x4){0u, 0u, 0u, 0u}; if (mb + i < M) raw[i] = *(const u32x4*)(colp + (size_t)(mb + i) * SM_NP); }
#pragma unroll
            for (int i = 0; i < 13; ++i) {
                const int m = mb + i;
                if (((m & (SEQ - 1)) == 0)) {
#pragma unroll
                    for (int e = 0; e < 8; ++e) { x0[e] = 0.f; x1[e] = 0.f; x2[e] = 0.f; }
                }
                unpack8(raw[i], x3);
                float v[8];
#pragma unroll
                for (int e = 0; e < 8; ++e) v[e] = siluf_(bb[e] + w[0][e] * x0[e] + w[1][e] * x1[e] + w[2][e] * x2[e] + w[3][e] * x3[e]);
                if (m < M) *(u32x4*)(colp + (size_t)m * SM_NP) = pack8(v);
#pragma unroll
                for (int e = 0; e < 8; ++e) { x0[e] = x1[e]; x1[e] = x2[e]; x2[e] = x3[e]; }
            }
        }
    }
}

constexpr int SST = 136;
__device__ __forceinline__ void ssd_job(const Params& P, int l, int b, int h, unsigned char* lds) {
    const int tid = ltid(), wave = __builtin_amdgcn_readfirstlane(tid >> 6);
    bf16_t* Cs = (bf16_t*)lds; bf16_t* Bs = Cs + 128 * SST; bf16_t* BsT = Bs + 128 * SST; bf16_t* XT = BsT + 128 * SST; bf16_t* Sb = XT + 64 * SST;
    float* dtv = (float*)(Sb + 64 * SST); float* acum = dtv + 128; float* scv = acum + 128; float* eav = scv + 128; float* tmpf = eav + 128;
    const bf16_t* Psm = (const bf16_t*)(P.ws + OFF_PSM); bf16_t* Yss = (bf16_t*)(P.ws + OFF_YM2);
    const int g = h >> 3;
    const float A_h = -__expf(P.in[I_ALOG][l * 16 + h]); const float Dh = P.in[I_M2D][l * 16 + h]; const float dtb = P.in[I_DTB][l * 16 + h];
    const size_t rowbase = (size_t)b * SEQ;
    int kind_o, q_o, seg_o;
    if (tid < 96) { kind_o = 0; q_o = tid / 12; seg_o = tid % 12; }
    else if (tid < 288) { kind_o = 1; q_o = (tid - 96) / 12; seg_o = (tid - 96) % 12; }
    else if (tid < 480) { kind_o = 2; q_o = (tid - 288) / 12; seg_o = (tid - 288) % 12; }
    else { kind_o = 3; q_o = 0; seg_o = 0; }
    const int ch = (kind_o == 1) ? (1024 + 128 * g + 8 * q_o) : (kind_o == 2) ? (1280 + 128 * g + 8 * q_o) : (64 * h + 8 * q_o);
    const int l0_o = 11 * seg_o, nrows_o = (kind_o == 3) ? 0 : ((128 - l0_o) < 11 ? (128 - l0_o) : 11);
    const bf16_t* srcb = Psm + rowbase * SM_NP + 2560 + ch;
    u32x4 raw[11]; float dtraw = 0.f;
#define SSD_ISSUE(cc) do { const int tb_ = (cc) * 128; \
        _Pragma("unroll") for (int i = 0; i < 11; ++i) { const int rr_ = (l0_o + i) < 127 ? (l0_o + i) : 127; raw[i] = *(const u32x4*)(srcb + (size_t)(tb_ + rr_) * SM_NP); } \
        if (tid < 128) dtraw = bf2f(((const bf16_t*)(P.ws + OFF_DT))[(rowbase + (cc) * 128 + tid) * 16 + h]); } while (0)
    SSD_ISSUE(0);
    __syncthreads();
    for (int i = tid; i < 64 * SST; i += 512) Sb[i] = 0;
    f32x16 Sacc = {};
    for (int c = 0; c < 16; ++c) {
        const int t0 = c * 128;
        LBAR();
        int tidc = tid; asm volatile("" : "+v"(tidc));
        const int lane = tidc & 63, r32 = lane & 31, hi = lane >> 5;
        int kind, q, seg;
        if (tidc < 96) { kind = 0; q = tidc / 12; seg = tidc % 12; }
        else if (tidc < 288) { kind = 1; q = (tidc - 96) / 12; seg = (tidc - 96) % 12; }
        else if (tidc < 480) { kind = 2; q = (tidc - 288) / 12; seg = (tidc - 288) % 12; }
        else { kind = 3; q = 0; seg = 0; }
        const int l0 = 11 * seg, nrows = (kind == 3) ? 0 : ((128 - l0) < 11 ? (128 - l0) : 11);
        if (kind < 3) {
#pragma unroll
            for (int i = 0; i < 11; ++i) {
                if (i < nrows) {
                    const int ll = l0 + i;
                    const u32x4 pk = raw[i];
                    if (kind == 0) {
#pragma unroll
                        for (int e = 0; e < 8; ++e) XT[(8 * q + e) * SST + ll] = (bf16_t)((e & 1) ? (pk[e >> 1] >> 16) : (pk[e >> 1] & 0xffffu));
                    } else if (kind == 1) {
                        *(u32x4*)(Bs + ll * SST + 8 * q) = pk;
#pragma unroll
                        for (int e = 0; e < 8; ++e) BsT[(8 * q + e) * SST + ll] = (bf16_t)((e & 1) ? (pk[e >> 1] >> 16) : (pk[e >> 1] & 0xffffu));
                    } else {
                        *(u32x4*)(Cs + ll * SST + 8 * q) = pk;
                    }
                }
            }
        }
        float a_inc = 0.f, dt_l = 0.f;
        if (tidc < 128) {
            dt_l = softplusf_(dtraw + dtb);
            float a = dt_l * A_h;
#pragma unroll
            for (int o = 1; o < 64; o <<= 1) { const float t = __shfl_up(a, o); if (lane >= o) a += t; }
            a_inc = a;
            if (tidc == 63) tmpf[0] = a;
        }
        if (c + 1 < 16) SSD_ISSUE(c + 1);
        LBAR();
        if (tidc < 128) { if (tidc >= 64) a_inc += tmpf[0]; acum[tidc] = a_inc; dtv[tidc] = dt_l; eav[tidc] = __expf(a_inc); }
        LBAR();
        const float atot = acum[127];
        if (tidc < 128) scv[tidc] = dt_l * __expf(atot - a_inc);
        f32x16 cb0 = {}, cb1 = {};
        const int tA = wave, trA = (int)((0x3333222110ull >> (4 * tA)) & 15), tcA = (int)((0x3210210100ull >> (4 * tA)) & 15);
        const int trB = 3, tcB = 2 + wave;
        {
#pragma unroll
            for (int k0 = 0; k0 < 128; k0 += 16) {
                const bf16x8 a = *(const bf16x8*)(Cs + (32 * trA + r32) * SST + k0 + 8 * hi);
                const bf16x8 bq = *(const bf16x8*)(Bs + (32 * tcA + r32) * SST + k0 + 8 * hi);
                cb0 = __builtin_amdgcn_mfma_f32_32x32x16_bf16(a, bq, cb0, 0, 0, 0);
            }
            if (wave < 2) {
#pragma unroll
                for (int k0 = 0; k0 < 128; k0 += 16) {
                    const bf16x8 a = *(const bf16x8*)(Cs + (32 * trB + r32) * SST + k0 + 8 * hi);
                    const bf16x8 bq = *(const bf16x8*)(Bs + (32 * tcB + r32) * SST + k0 + 8 * hi);
                    cb1 = __builtin_amdgcn_mfma_f32_32x32x16_bf16(a, bq, cb1, 0, 0, 0);
                }
            }
        }
        LBAR();
        {
#pragma unroll
            for (int r = 0; r < 16; ++r) {
                { const int ll = 32 * trA + crow(r, hi), sx = 32 * tcA + r32; const float v = (sx <= ll) ? cb0[r] * __expf(acum[ll] - acum[sx]) * dtv[sx] : 0.f; Bs[ll * SST + sx] = (bf16_t)f2bf(v); }
                if (wave < 2) { const int ll = 32 * trB + crow(r, hi), sx = 32 * tcB + r32; const float v = (sx <= ll) ? cb1[r] * __expf(acum[ll] - acum[sx]) * dtv[sx] : 0.f; Bs[ll * SST + sx] = (bf16_t)f2bf(v); }
            }
        }
        LBAR();
        {
            const int tr = wave >> 1, tc = wave & 1;
            f32x16 y2 = {}, y3 = {};
#pragma unroll 4
            for (int k0 = 0; k0 < 32 * (tr + 1); k0 += 16) {
                const bf16x8 a = *(const bf16x8*)(Bs + (32 * tr + r32) * SST + k0 + 8 * hi);
                const bf16x8 bq = *(const bf16x8*)(XT + (32 * tc + r32) * SST + k0 + 8 * hi);
                y2 = __builtin_amdgcn_mfma_f32_32x32x16_bf16(a, bq, y2, 0, 0, 0);
            }
#pragma unroll
            for (int k0 = 0; k0 < 128; k0 += 16) {
                const bf16x8 a = *(const bf16x8*)(Cs + (32 * tr + r32) * SST + k0 + 8 * hi);
                const bf16x8 bq = *(const bf16x8*)(Sb + (32 * tc + r32) * SST + k0 + 8 * hi);
                y3 = __builtin_amdgcn_mfma_f32_32x32x16_bf16(a, bq, y3, 0, 0, 0);
            }
            const int p = 32 * tc + r32;
#pragma unroll
            for (int r = 0; r < 16; ++r) {
                const int ll = 32 * tr + crow(r, hi);
                const float y = y2[r] + eav[ll] * y3[r] + Dh * bf2f(XT[p * SST + ll]);
                Yss[(rowbase + t0 + ll) * 1024 + 64 * h + p] = (bf16_t)f2bf(y);
            }
        }
        const int pt = wave >> 2, nt = wave & 3;
        {
            const float dtot = __expf(atot);
#pragma unroll
            for (int r = 0; r < 16; ++r) Sacc[r] *= dtot;
#pragma unroll
            for (int k0 = 0; k0 < 128; k0 += 16) {
                const u32x4 aw = *(const u32x4*)(XT + (32 * pt + r32) * SST + k0 + 8 * hi);
                float af[8]; unpack8(aw, af);
                const f32x4 s0 = *(const f32x4*)(scv + k0 + 8 * hi), s1 = *(const f32x4*)(scv + k0 + 8 * hi + 4);
                af[0] *= s0[0]; af[1] *= s0[1]; af[2] *= s0[2]; af[3] *= s0[3]; af[4] *= s1[0]; af[5] *= s1[1]; af[6] *= s1[2]; af[7] *= s1[3];
                const u32x4 a2 = pack8(af);
                const bf16x8 a = __builtin_bit_cast(bf16x8, a2);
                const bf16x8 bq = *(const bf16x8*)(BsT + (32 * nt + r32) * SST + k0 + 8 * hi);
                Sacc = __builtin_amdgcn_mfma_f32_32x32x16_bf16(a, bq, Sacc, 0, 0, 0);
            }
        }
        LBAR();
#pragma unroll
        for (int r = 0; r < 16; ++r) Sb[(32 * pt + crow(r, hi)) * SST + 32 * nt + r32] = (bf16_t)f2bf(Sacc[r]);
    }
#undef SSD_ISSUE
    __syncthreads();
}

__device__ __forceinline__ void phase_m2_post(const Params& P, int l) {
    const int tid = ltid(), lane = tid & 63, wave = tid >> 6;
    const int gw = blockIdx.x * 8 + wave, NGW = gridDim.x * 8;
    const bf16_t* Psm = (const bf16_t*)(P.ws + OFF_PSM); bf16_t* Y = (bf16_t*)(P.ws + OFF_YM2);
    const float* ng = P.in[I_M2NG] + l * 1024;
    for (int it = gw; it < M * 2; it += NGW) {
        const int m = it >> 1, g = it & 1, ch = 512 * g + 8 * lane;
        const u32x4 yw = *(const u32x4*)(Y + (size_t)m * 1024 + ch), zw = *(const u32x4*)(Psm + (size_t)m * SM_NP + 1536 + ch);
        float y[8], z[8]; unpack8(yw, y); unpack8(zw, z);
        float ss = 0.f;
#pragma unroll
        for (int i = 0; i < 8; ++i) { y[i] *= siluf_(z[i]); ss += y[i] * y[i]; }
        const float rstd = 1.0f / sqrtf(wave_sum(ss) * (1.f / 512.f) + 1e-6f);
#pragma unroll
        for (int i = 0; i < 8; ++i) y[i] = y[i] * rstd * ng[ch + i];
        *(u32x4*)(Y + (size_t)m * 1024 + ch) = pack8(y);
    }
}

__device__ __forceinline__ void phase_ffn_fixup(const Params& P, int l) {
    const bf16_t* Ue = (const bf16_t*)(P.ws + OFF_UE); bf16_t* GU = (bf16_t*)(P.ws + OFF_GU);
    const float* cw = P.in[I_FCW] + (size_t)l * 3 * UP_N; const float* cb = P.in[I_FCB] + (size_t)l * UP_N;
    const int total = (M / 64) * 352, stride = gridDim.x * 512;
    for (int it = blockIdx.x * 512 + ltid(); it < total; it += stride) {
        const int grp = it / 352, j = (it - grp * 352) * 8; const bool first = (grp & 31) == 0;
        const bf16_t* e = Ue + (size_t)grp * 4 * UP_N; const bf16_t* p = Ue + (size_t)(first ? grp : grp - 1) * 4 * UP_N;
        float g_m2[8], g_m1[8], g_0[8], g_1[8], v_m2[8], v_m1[8], v_0[8], v_1[8];
        unpack8(*(const u32x4*)(p + 2 * UP_N + j), g_m2); unpack8(*(const u32x4*)(p + 3 * UP_N + j), g_m1); unpack8(*(const u32x4*)(e + j), g_0); unpack8(*(const u32x4*)(e + UP_N + j), g_1);
        unpack8(*(const u32x4*)(p + 2 * UP_N + DFF + j), v_m2); unpack8(*(const u32x4*)(p + 3 * UP_N + DFF + j), v_m1); unpack8(*(const u32x4*)(e + DFF + j), v_0); unpack8(*(const u32x4*)(e + UP_N + DFF + j), v_1);
        float o0[8], o1[8];
#pragma unroll
        for (int i = 0; i < 8; ++i) {
            const float zg2 = first ? 0.f : g_m2[i], zg1 = first ? 0.f : g_m1[i], zv2 = first ? 0.f : v_m2[i], zv1 = first ? 0.f : v_m1[i];
            const float wg0 = cw[j + i], wg1 = cw[UP_N + j + i], wg2 = cw[2 * UP_N + j + i], bg = cb[j + i];
            const float wv0 = cw[DFF + j + i], wv1 = cw[UP_N + DFF + j + i], wv2 = cw[2 * UP_N + DFF + j + i], bv = cb[DFF + j + i];
            o0[i] = siluf_(bg + wg0 * zg2 + wg1 * zg1 + wg2 * g_0[i]) * (bv + wv0 * zv2 + wv1 * zv1 + wv2 * v_0[i]);
            o1[i] = siluf_(bg + wg0 * zg1 + wg1 * g_0[i] + wg2 * g_1[i]) * (bv + wv0 * zv1 + wv1 * v_0[i] + wv2 * v_1[i]);
        }
        *(u32x4*)(GU + (size_t)(64 * grp) * DFF + j) = pack8(o0); *(u32x4*)(GU + (size_t)(64 * grp + 1) * DFF + j) = pack8(o1);
    }
}

__device__ __forceinline__ void run_gemm(unsigned char* lds, const bf16_t* A, const bf16_t* Bt, int Mrows, int N, int K, const EpiX& E, int G, int c) {
    pg8::Gemm g{A, Bt, Mrows, N, K}; pg8::StaticOrder S; S.init(Mrows, N, G, c);
    pg8::gemm_phase<EpiX, pg8::StaticOrder, true, true>((LAS unsigned char*)lds, g, S, E);
    __syncthreads();
}

__global__ void __launch_bounds__(512, 2) fwd_megakernel(Params P) {
    extern __shared__ __attribute__((aligned(16))) unsigned char lds[];
    cg::grid_group grid = cg::this_grid();
    unsigned char* ws = P.ws;
    volatile LAS unsigned* bst = (volatile LAS unsigned*)((LAS unsigned char*)lds + (LDS_BYTES - 64));
    if (threadIdx.x < 2) bst[threadIdx.x] = 0u;
    __syncthreads();
    XcdBarrier xbar = xcd_barrier_post((unsigned*)(ws + OFF_BAR), bst);
#define GSYNC() xcd_barrier(xbar)
    const float* mod = (const float*)(ws + OFF_MOD);
    bf16_t* XN = (bf16_t*)(ws + OFF_XN);
    phase_mod(P, lds);
    for (int l = 0; l < NL; ++l) {
        const float* ml = mod + (size_t)l * 8 * 6144;
        const float* xin = (l == 0) ? P.in[I_X] : nullptr;
        bf16_t* XB = (bf16_t*)P.out + (size_t)M * 1024;
        phase_convert(P, l, lds);
#if (PROBE_MASK & 64)
        phase_convert(P, l, lds);
#endif
        if (P.ws == nullptr) grid.sync();
        if (l == 0) GSYNC();
        phase_norm_mod(xin, XB, P.in[I_N1G] + l * 1024, ml + 0 * 1024, ml + 1 * 1024, XN);
        GSYNC();
        for (int step = 0; step < 18; ++step) {
            EpiX E{}; const bf16_t* A = XN; const bf16_t* Bt = nullptr; int N = 1024, K = 1024; bool do_gemm = true; bool sync_after = true;
            int gG = (int)gridDim.x, gC = (int)blockIdx.x;
            bf16_t* GS0 = (bf16_t*)P.out;
            switch (step) {
                case 0: Bt = (const bf16_t*)(ws + OFF_WRW); N = PRW_LD; E.mode = 0; E.Ob = (bf16_t*)(ws + OFF_PRW); E.ldc = PRW_LD; break;
                case 1: do_gemm = false; phase_rwkv_pre(P, l, lds);
#if (PROBE_MASK & 1)
                        GSYNC(); phase_rwkv_pre(P, l, lds);
#endif
                        break;
                case 2: do_gemm = false; phase_scan(P, lds);
#if (PROBE_MASK & 2)
                        GSYNC(); phase_scan(P, lds);
#endif
                        break;
                case 3: do_gemm = false; phase_rwkv_post(P, l);
#if (PROBE_MASK & 256)
                        phase_rwkv_post(P, l);
#endif
                        break;
                case 4: Bt = (const bf16_t*)(ws + OFF_WSM); N = SM_NP; E.mode = 0; E.Ob = (bf16_t*)(ws + OFF_PSM); E.ldc = SM_NP; break;
                case 5: do_gemm = false; phase_xbc_conv(P, l, xbar); GSYNC();
                        if ((blockIdx.x & 1) == 0) { for (int job = blockIdx.x >> 1; job < 128; job += (gridDim.x + 1) >> 1) ssd_job(P, l, job >> 4, job & 15, lds); }
                        else { phase_attn(P, lds); __syncthreads();
                               do_gemm = true; Bt = (const bf16_t*)(ws + OFF_WG); N = 1024; E.mode = 1; E.Ob = GS0; E.ldc = 1024; gG = (int)gridDim.x >> 1; gC = (int)blockIdx.x >> 1; }
                        break;
                case 6: do_gemm = false; phase_m2_post(P, l);
                        break;
                case 7: Bt = (const bf16_t*)(ws + OFF_WG) + (size_t)1024 * 1024; N = 2048; E.mode = 1; E.Ob = (bf16_t*)(ws + OFF_GS); E.ldc = 1024; break;
                case 8: case 10: case 12: { const int i = (step - 8) >> 1; sync_after = (i == 2);
                        A = (const bf16_t*)(ws + (i == 0 ? OFF_YRW : i == 1 ? OFF_YSB : OFF_YM2));
                        Bt = (const bf16_t*)(ws + (i == 0 ? OFF_WRWO : i == 1 ? OFF_WSBO : OFF_WM2O)); K = (i == 2) ? 1024 : 512;
                        E.mode = 2 + i; E.Gs = (i == 0) ? (const bf16_t*)GS0 : (const bf16_t*)(ws + OFF_GS) + (size_t)(i - 1) * M * 1024; E.Ob = (bf16_t*)(ws + OFF_MB); E.ldc = 1024; } break;
                case 9: case 11: do_gemm = false; sync_after = false; break;
                case 13: A = (const bf16_t*)(ws + OFF_MB); Bt = (const bf16_t*)(ws + OFF_WOUT); E.mode = 5; E.xin = xin; E.xinb = XB; E.xoutb = XB; E.gate = ml + 2 * 1024; break;
                case 14: do_gemm = false; phase_norm_mod(nullptr, XB, P.in[I_N2G] + l * 1024, ml + 3 * 1024, ml + 4 * 1024, XN); break;
                case 15: Bt = (const bf16_t*)(ws + OFF_WUP); N = UP_N; E.mode = 6; E.Ob = (bf16_t*)(ws + OFF_GU); E.ldc = DFF; E.Ue = (bf16_t*)(ws + OFF_UE);
                         E.cw = P.in[I_FCW] + (size_t)l * 3 * UP_N; E.cb = P.in[I_FCB] + (size_t)l * UP_N; break;
                case 16: do_gemm = false; phase_ffn_fixup(P, l); break;
                case 17: A = (const bf16_t*)(ws + OFF_GU); Bt = (const bf16_t*)(ws + OFF_WDOWN); K = DFF; E.mode = 5; E.xin = nullptr; E.xinb = XB; E.xoutb = XB; E.gate = ml + 5 * 1024; break;
            }
            int nrep = 1;
#if (PROBE_MASK & 512)
            if (step == 0 || step == 4) nrep = 2;
#endif
#if (PROBE_MASK & 1024)
            if (step == 15) nrep = 2;
#endif
#if (PROBE_MASK & 2048)
            if (step == 7) nrep = 2;
#endif
#if (PROBE_MASK & 4096)
            if (step == 8) nrep = 2;
#endif
#if (PROBE_MASK & 8192)
            if (step == 13 && l == 0) nrep = 2;
#endif
            if (do_gemm) for (int rep = 0; rep < nrep; ++rep) run_gemm(lds, A, Bt, M, N, K, E, gG, gC);
            if (sync_after) GSYNC();
#if (PROBE_MASK & 32)
            if (sync_after) { GSYNC(); GSYNC(); GSYNC(); GSYNC(); }
#endif
        }
    }
    phase_final_norm((const bf16_t*)P.out + (size_t)M * 1024, P.out, P.in[I_FNG], xbar);
}

extern "C" void kernel_launch(void* const* d_in, const int* in_sizes, int n_in, void* d_out, int out_size, void* d_ws, size_t ws_size, hipStream_t stream) {
    static int grid_blocks = 0;
    if (grid_blocks == 0) {
        if (n_in != 33 || ws_size < WS_ASSUMED) { fprintf(stderr, "kernel_launch: unexpected n_in %d / ws_size %zu\n", n_in, ws_size); grid_blocks = -1; return; }
        int dev = 0, cus = 0, per_cu = 0;
        hipGetDevice(&dev);
        hipDeviceGetAttribute(&cus, hipDeviceAttributeMultiprocessorCount, dev);
        hipFuncSetAttribute((const void*)fwd_megakernel, hipFuncAttributeMaxDynamicSharedMemorySize, LDS_BYTES);
        hipOccupancyMaxActiveBlocksPerMultiprocessor(&per_cu, (const void*)fwd_megakernel, 512, LDS_BYTES);
        if (per_cu < 1) { fprintf(stderr, "kernel_launch: occupancy query says %d blocks/CU\n", per_cu); per_cu = 1; }
        grid_blocks = cus * 1;
        (void)hipGetLastError();
    }
    if (grid_blocks < 0) return;
    Params p{};
    for (int i = 0; i < 33; ++i) p.in[i] = (const float*)d_in[i];
    p.out = (float*)d_out; p.ws = (unsigned char*)d_ws;
    if (hipMemsetAsync((char*)d_ws + OFF_BAR, 0, XCD_BAR_WORDS * 4, stream) != hipSuccess) { fprintf(stderr, "memset failed\n"); return; }
    void* args[] = {&p};
    hipError_t e = hipLaunchCooperativeKernel((const void*)fwd_megakernel, dim3(grid_blocks), dim3(512), args, LDS_BYTES, stream);
    if (e != hipSuccess) fprintf(stderr, "cooperative launch failed: %s (grid %d)\n", hipGetErrorString(e), grid_blocks);
}
```
